# Optimizing an MI355X kernel written in HIP

```python
import jax, jax.numpy as jnp
from jax import lax
import numpy as np

D_MODEL = 2048
BATCH = 2
SEQ = 4096
DEPTH = 1

CHUNK = 64
Q_BLOCK = 128
PLE_DIM = 256
FOX_HEADS = 8
FOX_HEAD_DIM = D_MODEL // 16
GLA_HEADS = 4
GLA_KEY_DIM = D_MODEL // 16
GLA_VAL_DIM = D_MODEL // 8
GLA_GATE_RANK = 16
GLA_GATE_TAU = 16.0
D_FF = ((8 * D_MODEL // 3 + 255) // 256) * 256
EPS = 1e-6

FOX_W = FOX_HEADS * FOX_HEAD_DIM
GLA_KW = GLA_HEADS * GLA_KEY_DIM
GLA_VW = GLA_HEADS * GLA_VAL_DIM
IN_SPLITS = (FOX_W, FOX_W, FOX_W, FOX_HEADS, GLA_KW, GLA_KW, GLA_VW, GLA_VW, GLA_GATE_RANK)
D_IN = sum(IN_SPLITS)

kernel_name = "hybrid_fox_gla_macaron_ple"


def rms_norm(x, g):
    xf = x.astype(jnp.float32)
    y = xf * lax.rsqrt(jnp.mean(xf * xf, axis=-1, keepdims=True) + EPS)
    return (y * g.astype(jnp.float32)).astype(x.dtype)


def swiglu(x, w_gate, w_up, w_down):
    return (jax.nn.silu(x @ w_gate) * (x @ w_up)) @ w_down


def split_cols(t, sizes):
    out, start = [], 0
    for s in sizes:
        out.append(t[..., start:start + s])
        start += s
    return out


def forgetting_attention(q, k, v, log_f):
    b, s, h, d = q.shape
    nb = s // Q_BLOCK
    f_cum = jnp.cumsum(log_f.astype(jnp.float32), axis=1).transpose(0, 2, 1)
    q_blocks = q.reshape(b, nb, Q_BLOCK, h, d).transpose(1, 0, 2, 3, 4)
    fq_blocks = f_cum.reshape(b, h, nb, Q_BLOCK).transpose(2, 0, 1, 3)
    key_pos = jnp.arange(s)
    scale = d ** -0.5

    def block(args):
        q_i, fq_i, i = args
        logits = jnp.einsum('bqhd,bkhd->bhqk', q_i, k).astype(jnp.float32) * scale
        logits = logits + fq_i[..., :, None] - f_cum[:, :, None, :]
        q_pos = i * Q_BLOCK + jnp.arange(Q_BLOCK)
        causal = key_pos[None, :] <= q_pos[:, None]
        logits = jnp.where(causal, logits, -jnp.inf)
        probs = jax.nn.softmax(logits, axis=-1).astype(v.dtype)
        return jnp.einsum('bhqk,bkhd->bqhd', probs, v)

    out = lax.map(block, (q_blocks, fq_blocks, jnp.arange(nb)))
    return out.transpose(1, 0, 2, 3, 4).reshape(b, s, h * d)


def gla_chunk_causal(q, k, v, log_a):
    b, s, h, dk = q.shape
    dv = v.shape[-1]
    nc = s // CHUNK

    def chunks(t):
        return t.astype(jnp.float32).reshape(b, nc, CHUNK, h, t.shape[-1]).transpose(1, 0, 2, 3, 4)

    qc, kc, vc, ac = chunks(q), chunks(k), chunks(v), chunks(log_a)
    a_cum = jnp.cumsum(ac, axis=2)
    a_tot = a_cum[:, :, -1]
    k_dec = kc * jnp.exp(a_tot[:, :, None] - a_cum)
    qc = qc * (dk ** -0.5)

    def step(state, inp):
        q_c, k_c, v_c, a_c = inp
        state = jnp.exp(a_c)[..., None] * state + jnp.einsum('bchk,bchv->bhkv', k_c, v_c)
        o = jnp.einsum('bchk,bhkv->bchv', q_c, state)
        return state, o

    state0 = jnp.zeros((b, h, dk, dv), jnp.float32)
    _, o = lax.scan(step, state0, (qc, k_dec, vc, a_tot))
    return o.transpose(1, 0, 2, 3, 4).reshape(b, s, h, dv)


def setup_inputs(seed: int = 0) -> dict:
    key = jax.random.key(seed)
    ks = iter(jax.random.split(key, 32))
    f32 = jnp.float32

    def w(shape, fan_in):
        return jax.random.normal(next(ks), (DEPTH,) + shape, f32) * (fan_in ** -0.5)

    def gain(shape):
        return 1.0 + 0.05 * jax.random.normal(next(ks), shape, f32)

    def bias(shape, mean=0.0, std=0.01):
        return mean + std * jax.random.normal(next(ks), shape, f32)

    return {
        "x": jax.random.normal(next(ks), (BATCH, SEQ, D_MODEL), f32),
        "p": jax.random.normal(next(ks), (DEPTH, BATCH, SEQ, PLE_DIM), f32),
        "ffn1_norm": gain((DEPTH, D_MODEL)),
        "ffn1_w_gate": w((D_MODEL, D_FF), D_MODEL),
        "ffn1_w_up": w((D_MODEL, D_FF), D_MODEL),
        "ffn1_w_down": w((D_FF, D_MODEL), D_FF),
        "mix_norm": gain((DEPTH, D_MODEL)),
        "w_in": w((D_MODEL, D_IN), D_MODEL),
        "fox_forget_bias": bias((DEPTH, FOX_HEADS), mean=3.0, std=0.1),
        "gla_gate_up": w((GLA_GATE_RANK, GLA_KW), GLA_GATE_RANK),
        "gla_gate_bias": bias((DEPTH, GLA_KW)),
        "gla_head_norm": gain((DEPTH, GLA_VAL_DIM)),
        "w_branch_fox": w((FOX_W, D_MODEL), FOX_W),
        "w_branch_gla": w((GLA_VW, D_MODEL), GLA_VW),
        "w_merge_gate": w((D_MODEL, 2 * D_MODEL), D_MODEL),
        "b_merge_gate": bias((DEPTH, 2 * D_MODEL)),
        "w_out": w((D_MODEL, D_MODEL), D_MODEL),
        "ffn2_norm": gain((DEPTH, D_MODEL)),
        "ffn2_w_gate": w((D_MODEL, D_FF), D_MODEL),
        "ffn2_w_up": w((D_MODEL, D_FF), D_MODEL),
        "ffn2_w_down": w((D_FF, D_MODEL), D_FF),
        "ple_norm": gain((DEPTH, D_MODEL)),
        "w_ple_proj": w((PLE_DIM, D_MODEL), PLE_DIM),
        "w_ple_gate": w((D_MODEL, D_MODEL), D_MODEL),
        "final_norm": gain((D_MODEL,)),
    }


def reference(x, p, ffn1_norm, ffn1_w_gate, ffn1_w_up, ffn1_w_down, mix_norm, w_in,
              fox_forget_bias, gla_gate_up, gla_gate_bias, gla_head_norm,
              w_branch_fox, w_branch_gla, w_merge_gate, b_merge_gate, w_out,
              ffn2_norm, ffn2_w_gate, ffn2_w_up, ffn2_w_down,
              ple_norm, w_ple_proj, w_ple_gate, final_norm):
    b, s, _ = x.shape
    h = x
    for i in range(DEPTH):
        h = h + 0.5 * swiglu(rms_norm(h, ffn1_norm[i]), ffn1_w_gate[i], ffn1_w_up[i], ffn1_w_down[i])

        u = rms_norm(h, mix_norm[i])
        (fq, fk, fv, f_logit, gq, gk, gv, gr, g_down) = split_cols(u @ w_in[i], IN_SPLITS)

        log_f = jax.nn.log_sigmoid((f_logit + fox_forget_bias[i]).astype(jnp.float32))
        y_fox = forgetting_attention(
            fq.reshape(b, s, FOX_HEADS, FOX_HEAD_DIM),
            fk.reshape(b, s, FOX_HEADS, FOX_HEAD_DIM),
            fv.reshape(b, s, FOX_HEADS, FOX_HEAD_DIM),
            log_f.astype(x.dtype))

        log_a = jax.nn.log_sigmoid((g_down @ gla_gate_up[i] + gla_gate_bias[i]).astype(jnp.float32)) / GLA_GATE_TAU
        o_gla = gla_chunk_causal(
            gq.reshape(b, s, GLA_HEADS, GLA_KEY_DIM),
            gk.reshape(b, s, GLA_HEADS, GLA_KEY_DIM),
            gv.reshape(b, s, GLA_HEADS, GLA_VAL_DIM),
            log_a.reshape(b, s, GLA_HEADS, GLA_KEY_DIM))
        o_gla = rms_norm(o_gla, gla_head_norm[i]).reshape(b, s, GLA_VW).astype(x.dtype)
        y_gla = o_gla * jax.nn.silu(gr)

        gates = jax.nn.sigmoid(u @ w_merge_gate[i] + b_merge_gate[i])
        g_fox, g_gla = gates[..., :D_MODEL], gates[..., D_MODEL:]
        merged = g_fox * (y_fox @ w_branch_fox[i]) + g_gla * (y_gla @ w_branch_gla[i])
        h = h + merged @ w_out[i]

        h = h + 0.5 * swiglu(rms_norm(h, ffn2_norm[i]), ffn2_w_gate[i], ffn2_w_up[i], ffn2_w_down[i])

        ple_gate = jax.nn.sigmoid(rms_norm(h, ple_norm[i]) @ w_ple_gate[i])
        h = h + ple_gate * (p[i].astype(h.dtype) @ w_ple_proj[i])
    return rms_norm(h, final_norm)
```

```cpp
#include <hip/hip_runtime.h>
#include <hip/hip_cooperative_groups.h>
#include <hip/hip_bf16.h>
#include <cstdio>
#include <cstdint>
#include <cmath>
namespace cg = cooperative_groups;

constexpr int NB = 2, SEQ = 4096, T = NB * SEQ, DM = 2048, DFF = 5632, DIN = 6168;
constexpr int FOXH = 8, HD = 128, GLAH = 4, GKD = 128, GVD = 256, RANK = 16, PLE = 256, CHUNK = 64, NCH = SEQ / CHUNK;
constexpr float EPS = 1e-6f;
constexpr int N4 = 10240;

constexpr size_t MiB = 1u << 20;
constexpr size_t SZ_WGU = (size_t)2 * DFF * DM * 2, SZ_WD = (size_t)DM * DFF * 2;
constexpr size_t WS_WGU1 = 0;
constexpr size_t WS_WD1 = WS_WGU1 + SZ_WGU;
constexpr size_t WS_GATES = 0;
constexpr size_t WS_W4 = WS_WD1 + SZ_WD;
constexpr size_t WS_WA = WS_W4 + (size_t)N4 * DM * 2;
constexpr size_t WS_WB = WS_WA + (size_t)DM * 1024 * 2;
constexpr size_t WS_WOUT = WS_WB + (size_t)DM * 1024 * 2;
constexpr size_t WS_WGU2 = WS_WOUT + (size_t)DM * DM * 2;
constexpr size_t WS_WD2 = WS_WGU2 + SZ_WGU;
constexpr size_t WS_WPG = WS_WD2 + SZ_WD;
constexpr size_t WS_WPE = WS_WPG + (size_t)DM * DM * 2;
constexpr size_t WS_WSM = WS_WPE + (size_t)DM * PLE * 2;
constexpr size_t WS_XN = ((WS_WSM + (size_t)24 * DM * 4 + 4095) / 4096) * 4096;
constexpr size_t WS_ACT = WS_XN + (size_t)T * DM * 2;
constexpr size_t WS_FQ = WS_ACT, WS_FK = WS_FQ + (size_t)T * 1024 * 2, WS_FV = WS_FK + (size_t)T * 1024 * 2;
constexpr size_t WS_GQ = WS_FV + (size_t)T * 1024 * 2, WS_GK = WS_GQ + (size_t)T * 512 * 2, WS_GV = WS_GK + (size_t)T * 512 * 2;
constexpr size_t WS_Z1 = WS_ACT;
constexpr size_t WS_PE = 0;
constexpr size_t WS_SGR = WS_ACT + (size_t)T * DFF * 2;
constexpr size_t WS_YF = WS_SGR + (size_t)T * 1024 * 2;
constexpr size_t WS_YG = WS_YF + (size_t)T * 1024 * 2;
constexpr size_t WS_KV = WS_YG + (size_t)T * 1024 * 2;
constexpr size_t WS_PB = WS_KV + (size_t)64 * MiB;
constexpr size_t WS_LA = WS_PB + (size_t)T * PLE * 2;
constexpr size_t WS_LF = WS_LA + (size_t)T * 512 * 4;
constexpr size_t WS_FS = WS_LF + (size_t)T * 8 * 4;
constexpr size_t WS_DEC = WS_FS + (size_t)16 * SEQ * 4;
constexpr size_t WS_BAR = WS_DEC + (size_t)8 * 64 * 128 * 4;
constexpr size_t WS_SSQ = WS_BAR + 32768;
constexpr size_t WS_XN2 = WS_KV;
constexpr size_t WS_END = WS_SSQ + (size_t)5 * T * 4;
static_assert(WS_WGU1 + SZ_WGU + SZ_WD >= WS_GATES + (size_t)T * 4096 * 2, "gates overlay");
static_assert(WS_GV + (size_t)T * 1024 * 2 <= WS_SGR, "mixer temporaries inside ACT");

constexpr int LDS_BYTES = 147456;
constexpr int LDS_AUX = 131072;

struct Args { const float* in[25]; float* out; unsigned char* ws; };

__device__ __forceinline__ float dpp_f(float v, const int ctrl_sel) {
    const int x = __builtin_bit_cast(int, v); int r;
    if (ctrl_sel == 0) r = __builtin_amdgcn_update_dpp(0, x, 0xB1, 0xf, 0xf, false);
    else if (ctrl_sel == 1) r = __builtin_amdgcn_update_dpp(0, x, 0x4E, 0xf, 0xf, false);
    else if (ctrl_sel == 2) r = __builtin_amdgcn_update_dpp(0, x, 0x141, 0xf, 0xf, false);
    else r = __builtin_amdgcn_update_dpp(0, x, 0x140, 0xf, 0xf, false);
    return __builtin_bit_cast(float, r);
}
__device__ __forceinline__ float wave_sum(float v) {
    v += dpp_f(v, 0); v += dpp_f(v, 1); v += dpp_f(v, 2); v += dpp_f(v, 3);
    v += __shfl_xor(v, 16);
    { auto rr = __builtin_amdgcn_permlane32_swap(__float_as_uint(v), __float_as_uint(v), false, false); v = __uint_as_float(rr[0]) + __uint_as_float(rr[1]); }
    return v;
}
__device__ __forceinline__ unsigned f2bf(float f) { unsigned u = __builtin_bit_cast(unsigned, f); return (u + 0x7fffu + ((u >> 16) & 1u)) >> 16; }
__device__ __forceinline__ unsigned pk2(float lo, float hi) { return f2bf(lo) | (f2bf(hi) << 16); }
__device__ __forceinline__ float bf2f(unsigned short b) { return __builtin_bit_cast(float, (unsigned)b << 16); }
__device__ __forceinline__ float sigmoid_f(float x) { return __builtin_amdgcn_rcpf(1.0f + __builtin_amdgcn_exp2f(-1.4426950408889634f * x)); }
__device__ __forceinline__ float silu_f(float x) { return x * sigmoid_f(x); }
__device__ __forceinline__ float logsigmoid_f(float x) { return fminf(x, 0.f) - __logf(1.0f + __expf(-fabsf(x))); }

__device__ __forceinline__ int opaque_tid() { int t = (int)threadIdx.x; asm volatile("" : "+v"(t)); return t; }

namespace pg8 {
#define PG8_LAS __attribute__((address_space(3)))
typedef unsigned short bf16_t;
typedef short bf16x8 __attribute__((ext_vector_type(8)));
typedef float f32x4 __attribute__((ext_vector_type(4)));
typedef unsigned u32x4 __attribute__((ext_vector_type(4)));
constexpr int BM = 256, BK = 64, HALF = 128, HTB = HALF * BK * 2  , STAGE_BYTES = 8 * HTB, NXCD = 8, WGM = 8;

__host__ __device__ __forceinline__ int lds_byte(int r, int c) { const int st = (r >> 4) * 2 + (c >> 5), rr = r & 15, cc = c & 31, ob = rr * 64 + cc * 2; return st * 1024 + (ob ^ (((ob >> 9) & 1) << 5)); }
__host__ __device__ __forceinline__ void stage_rc(int b, int& R, int& C) { const int st = b / 1024, sb = b % 1024, swz = sb ^ (((sb >> 9) & 1) << 5); R = (st >> 1) * 16 + swz / 64; C = (st & 1) * 32 + (swz % 64) / 2; }
__host__ __device__ __forceinline__ int perm32(int rho) { const int n = rho >> 4, i = rho & 15; return 8 * (i >> 2) + 4 * n + (i & 3); }

struct Unit { int pm, pn; };
struct Gemm { const bf16_t* A; const bf16_t* Bt; int M, N, K; };

struct StaticOrder {
    int nM, nN, nwg, G, c;
    __host__ __device__ void init(int M, int N, int G_, int c_) { nM = M / BM; nN = N / BM; nwg = nM * nN; G = G_; c = c_; }
    __host__ __device__ bool next(int i, Unit& u) const {
        const long L = (long)i * G + c; if (L >= nwg) return false;
        int wgid = (int)L; { const int q = nwg / NXCD, r = nwg % NXCD, xcd = wgid % NXCD, off = wgid / NXCD; wgid = (xcd < r ? xcd * (q + 1) : r * (q + 1) + (xcd - r) * q) + off; }
        const int nig = WGM * nN, gid = wgid / nig, fm = gid * WGM, gsz = (nM - fm) < WGM ? (nM - fm) : WGM;
        u.pm = fm + ((wgid % nig) % gsz); u.pn = (wgid % nig) / gsz; return true;
    }
    __device__ __forceinline__ void a_ready(const Unit&) const {}
    __device__ __forceinline__ void done(const Unit&) const {}
};

template <class Epi, class Sched, bool ALIGN_EPI = false, bool SP2 = false>
__device__ __forceinline__ void gemm_phase(PG8_LAS unsigned char* lds, const Gemm g, const Sched& S, const Epi& E) {
    const int tid = opaque_tid(), wid = __builtin_amdgcn_readfirstlane(tid >> 6), lane = tid & 63, wr = wid >> 2, wc = wid & 3, fr = lane & 15, fq = lane >> 4;
    const int K = g.K, nt = K / BK;
    unsigned voffA[2], voffB[2];
#pragma unroll
    for (int i = 0; i < 2; ++i) { int R, C; stage_rc(tid * 16 + i * 8192, R, C); const int Rb = Epi::PERM ? ((R & ~31) + perm32(R & 31)) : R;
        voffA[i] = (unsigned)(R * K + C) * 2u; voffB[i] = (unsigned)(Rb * K + C) * 2u; }
    const size_t kstep = (size_t)(BK * 2);
    const size_t hstep = (size_t)HALF * K * 2;
    const size_t tstep = 2 * hstep;
    const unsigned ldsw = (unsigned)wid * 1024u;
    const int aoff = lds_byte(wr * 64 + fr, fq * 8), boff = lds_byte(wc * 32 + fr, fq * 8);
#define PG8_SA(b, h) (((b) * 2 + (h)) * HTB)
#define PG8_SB(b, h) ((4 + (b) * 2 + (h)) * HTB)
#define PG8_STAGE(bufoff, gbase, voff) do { _Pragma("unroll") for (int _i = 0; _i < 2; ++_i) \
        __builtin_amdgcn_global_load_lds((const unsigned*)((const char*)(gbase) + (voff)[_i]), (PG8_LAS unsigned*)(lds + (bufoff) + ldsw + _i * 8192), 16, 0, 0); } while (0)
#define PG8_LDA(dst, b, h) do { _Pragma("unroll") for (int m = 0; m < 4; ++m) _Pragma("unroll") for (int k = 0; k < 2; ++k) dst[m][k] = *(const PG8_LAS bf16x8*)(lds + PG8_SA(b, h) + aoff + m * 2048 + k * 1024); } while (0)
#define PG8_LDB(dst, b, h) do { _Pragma("unroll") for (int n = 0; n < 2; ++n) _Pragma("unroll") for (int k = 0; k < 2; ++k) dst[n][k] = *(const PG8_LAS bf16x8*)(lds + PG8_SB(b, h) + boff + n * 2048 + k * 1024); } while (0)
#define PG8_MMA(ai, bj, At, Bt) do { __builtin_amdgcn_s_setprio(1); _Pragma("unroll") for (int m = 0; m < 4; ++m) _Pragma("unroll") for (int n = 0; n < 2; ++n) _Pragma("unroll") for (int k = 0; k < 2; ++k) \
        acc[ai][bj][m][n] = __builtin_amdgcn_mfma_f32_16x16x32_bf16(Bt[n][k], At[m][k], acc[ai][bj][m][n], 0, 0, 0); __builtin_amdgcn_s_setprio(0); } while (0)
#define PG8_WAIT_V(n) asm volatile("s_waitcnt vmcnt(" #n ")" ::: "memory")
#define PG8_WAIT_L(n) asm volatile("s_waitcnt lgkmcnt(" #n ")" ::: "memory")
#define PG8_BAR __builtin_amdgcn_s_barrier()
#define PG8_SCHED __builtin_amdgcn_sched_barrier(0)
    Unit cur, nxt; int ui = 0;
    if (!S.next(0, cur)) return;
    f32x4 acc[2][2][4][2];
#pragma unroll
    for (int a = 0; a < 2; ++a)
#pragma unroll
        for (int b = 0; b < 2; ++b)
#pragma unroll
            for (int m = 0; m < 4; ++m)
#pragma unroll
                for (int n = 0; n < 2; ++n) acc[a][b][m][n] = (f32x4){0.f, 0.f, 0.f, 0.f};
    bf16x8 At[4][2], B0[2][2], B1[2][2];
    const char* cA = (const char*)g.A + (size_t)cur.pm * tstep; const char* cB = (const char*)g.Bt + (size_t)cur.pn * tstep;
    S.a_ready(cur);
    if constexpr (SP2) {
        PG8_STAGE(PG8_SB(0, 0), cB, voffB); PG8_STAGE(PG8_SB(0, 1), cB + hstep, voffB); PG8_STAGE(PG8_SA(0, 0), cA, voffA); PG8_STAGE(PG8_SA(0, 1), cA + hstep, voffA);
        if (wr == 1) PG8_BAR;
        PG8_WAIT_V(2); PG8_BAR;
        PG8_STAGE(PG8_SB(1, 0), cB + kstep, voffB); PG8_STAGE(PG8_SA(1, 0), cA + kstep, voffA); PG8_STAGE(PG8_SB(1, 1), cB + hstep + kstep, voffB);
        PG8_WAIT_V(6); PG8_BAR;
    } else {
        PG8_STAGE(PG8_SB(0, 0), cB, voffB); PG8_STAGE(PG8_SA(0, 0), cA, voffA); PG8_STAGE(PG8_SB(0, 1), cB + hstep, voffB); PG8_STAGE(PG8_SA(0, 1), cA + hstep, voffA);
        if (wr == 1) PG8_BAR;
        PG8_WAIT_V(4); PG8_BAR;
        PG8_STAGE(PG8_SB(1, 0), cB + kstep, voffB); PG8_STAGE(PG8_SA(1, 0), cA + kstep, voffA); PG8_STAGE(PG8_SB(1, 1), cB + hstep + kstep, voffB);
        PG8_WAIT_V(6); PG8_BAR;
    }
    for (;;) {
        const bool has_next = S.next(ui + 1, nxt);
        const char* nA = has_next ? (const char*)g.A + (size_t)nxt.pm * tstep : cA; const char* nB = has_next ? (const char*)g.Bt + (size_t)nxt.pn * tstep : cB;
        for (int t = 0; t < nt; t += 2) {
            if constexpr (Epi::MIDK) { if (t == (nt >> 1)) E.mid(acc, cur, wr, wc, fr, fq); }
            const bool last = (t == nt - 2);
            const char* a1 = cA + (size_t)(t + 1) * kstep;
            const char* a2 = last ? nA : cA + (size_t)(t + 2) * kstep; const char* b2 = last ? nB : cB + (size_t)(t + 2) * kstep;
            const char* a3 = a2 + kstep; const char* b3 = b2 + kstep;
            if (last && has_next) S.a_ready(nxt);
            if constexpr (SP2) {
            PG8_LDB(B0, 0, 0); PG8_LDB(B1, 0, 1); PG8_SCHED; PG8_LDA(At, 0, 0); PG8_STAGE(PG8_SA(1, 1), a1 + hstep, voffA);
            PG8_WAIT_V(8); PG8_WAIT_L(0); PG8_BAR; PG8_MMA(0, 0, At, B0); PG8_MMA(0, 1, At, B1); PG8_BAR; PG8_SCHED;
            PG8_LDA(At, 0, 1); PG8_STAGE(PG8_SB(0, 0), b2, voffB); PG8_STAGE(PG8_SB(0, 1), b2 + hstep, voffB); PG8_STAGE(PG8_SA(0, 0), a2, voffA);
            PG8_WAIT_V(8); PG8_WAIT_L(0); PG8_BAR; PG8_MMA(1, 0, At, B0); PG8_MMA(1, 1, At, B1); PG8_BAR; PG8_SCHED;
            PG8_LDB(B0, 1, 0); PG8_LDB(B1, 1, 1); PG8_SCHED; PG8_LDA(At, 1, 0); PG8_STAGE(PG8_SA(0, 1), a2 + hstep, voffA);
            PG8_WAIT_V(8); PG8_WAIT_L(0); PG8_BAR; PG8_MMA(0, 0, At, B0); PG8_MMA(0, 1, At, B1); PG8_BAR; PG8_SCHED;
            PG8_LDA(At, 1, 1); PG8_STAGE(PG8_SB(1, 0), b3, voffB); PG8_STAGE(PG8_SB(1, 1), b3 + hstep, voffB); PG8_STAGE(PG8_SA(1, 0), a3, voffA);
            PG8_WAIT_V(8); PG8_WAIT_L(0); PG8_BAR; PG8_MMA(1, 0, At, B0); PG8_MMA(1, 1, At, B1); PG8_BAR; PG8_SCHED;
            } else {
            PG8_LDB(B0, 0, 0); PG8_SCHED; PG8_LDA(At, 0, 0); PG8_STAGE(PG8_SA(1, 1), a1 + hstep, voffA);
            PG8_WAIT_L(8); PG8_BAR; PG8_WAIT_L(0); PG8_MMA(0, 0, At, B0); PG8_BAR; PG8_SCHED;
            PG8_LDB(B1, 0, 1); PG8_STAGE(PG8_SB(0, 0), b2, voffB);
            PG8_BAR; PG8_WAIT_L(0); PG8_MMA(0, 1, At, B1); PG8_BAR;
            PG8_LDA(At, 0, 1); PG8_STAGE(PG8_SA(0, 0), a2, voffA);
            PG8_BAR; PG8_WAIT_L(0); PG8_MMA(1, 0, At, B0); PG8_BAR; PG8_SCHED;
            PG8_STAGE(PG8_SB(0, 1), b2 + hstep, voffB);
            PG8_WAIT_V(6); PG8_BAR; PG8_MMA(1, 1, At, B1); PG8_BAR;
            PG8_LDB(B0, 1, 0); PG8_SCHED; PG8_LDA(At, 1, 0); PG8_STAGE(PG8_SA(0, 1), a2 + hstep, voffA);
            PG8_WAIT_L(8); PG8_BAR; PG8_WAIT_L(0); PG8_MMA(0, 0, At, B0); PG8_BAR; PG8_SCHED;
            PG8_LDB(B1, 1, 1); PG8_STAGE(PG8_SB(1, 0), b3, voffB);
            PG8_BAR; PG8_WAIT_L(0); PG8_MMA(0, 1, At, B1); PG8_BAR;
            PG8_LDA(At, 1, 1); PG8_STAGE(PG8_SA(1, 0), a3, voffA);
            PG8_BAR; PG8_WAIT_L(0); PG8_MMA(1, 0, At, B0); PG8_BAR; PG8_SCHED;
            PG8_STAGE(PG8_SB(1, 1), b3 + hstep, voffB);
            PG8_WAIT_V(6); PG8_BAR; PG8_MMA(1, 1, At, B1); PG8_BAR;
            }
        }
        if constexpr (ALIGN_EPI) { if (wr == 0) PG8_BAR; }
        if constexpr (!Epi::AFTER_DRAIN) { E(acc, cur, wr, wc, fr, fq); S.done(cur); }
        if (!has_next) break;
#pragma unroll
        for (int a = 0; a < 2; ++a)
#pragma unroll
            for (int b = 0; b < 2; ++b)
#pragma unroll
                for (int m = 0; m < 4; ++m)
#pragma unroll
                    for (int n = 0; n < 2; ++n) acc[a][b][m][n] = (f32x4){0.f, 0.f, 0.f, 0.f};
        cur = nxt; cA = nA; cB = nB; ++ui;
        if constexpr (ALIGN_EPI) { if (wr == 1) PG8_BAR; }
    }
    PG8_WAIT_V(0);
    if constexpr (!ALIGN_EPI) { if (wr == 0) PG8_BAR; }
    PG8_BAR;
    if constexpr (Epi::AFTER_DRAIN) { E.fused(acc, cur, wr, wc, fr, fq, lds, wid, lane); S.done(cur); }
#undef PG8_SA
#undef PG8_SB
#undef PG8_STAGE
#undef PG8_LDA
#undef PG8_LDB
#undef PG8_MMA
#undef PG8_WAIT_V
#undef PG8_WAIT_L
#undef PG8_BAR
#undef PG8_SCHED
}
}
namespace pg8 {
__device__ __forceinline__ unsigned cvt_pk_bf16(float lo, float hi) { unsigned r; asm volatile("v_cvt_pk_bf16_f32 %0, %1, %2" : "=v"(r) : "v"(lo), "v"(hi)); return r; }
enum { EPI_SWIGLU = 0, EPI_RES = 1, EPI_P4 = 2, EPI_Z1 = 3, EPI_MERGE = 4, EPI_PLE = 5, EPI_PE = 6, EPI_FINAL = 7, EPI_MERGE2 = 8 };
__device__ __forceinline__ u32x4 pack8bf(f32x4 a, f32x4 b) { u32x4 w; w.x = cvt_pk_bf16(a[0], a[1]); w.y = cvt_pk_bf16(a[2], a[3]); w.z = cvt_pk_bf16(b[0], b[1]); w.w = cvt_pk_bf16(b[2], b[3]); return w; }
__device__ __forceinline__ void unpack8bf(u32x4 w, f32x4& a, f32x4& b) {
    a[0] = __builtin_bit_cast(float, w.x << 16); a[1] = __builtin_bit_cast(float, w.x & 0xffff0000u); a[2] = __builtin_bit_cast(float, w.y << 16); a[3] = __builtin_bit_cast(float, w.y & 0xffff0000u);
    b[0] = __builtin_bit_cast(float, w.z << 16); b[1] = __builtin_bit_cast(float, w.z & 0xffff0000u); b[2] = __builtin_bit_cast(float, w.w << 16); b[3] = __builtin_bit_cast(float, w.w & 0xffff0000u); }
__device__ __forceinline__ f32x4 sig4(f32x4 v) { f32x4 r; r[0] = sigmoid_f(v[0]); r[1] = sigmoid_f(v[1]); r[2] = sigmoid_f(v[2]); r[3] = sigmoid_f(v[3]); return r; }
__device__ __forceinline__ f32x4 silu4(f32x4 v) { return v * sig4(v); }
typedef unsigned u32x2 __attribute__((ext_vector_type(2)));
__device__ __forceinline__ unsigned q8(float g) { return (unsigned)fminf(fmaxf(g * 255.0f + 0.5f, 1.0f), 255.0f); }
__device__ __forceinline__ u32x2 pack8u8(f32x4 a, f32x4 b) { u32x2 w; w.x = q8(a[0]) | (q8(a[1]) << 8) | (q8(a[2]) << 16) | (q8(a[3]) << 24); w.y = q8(b[0]) | (q8(b[1]) << 8) | (q8(b[2]) << 16) | (q8(b[3]) << 24); return w; }
__device__ __forceinline__ void unpack8u8(u32x2 w, f32x4& a, f32x4& b) {
    a[0] = (float)(w.x & 0xffu); a[1] = (float)((w.x >> 8) & 0xffu); a[2] = (float)((w.x >> 16) & 0xffu); a[3] = (float)(w.x >> 24);
    b[0] = (float)(w.y & 0xffu); b[1] = (float)((w.y >> 8) & 0xffu); b[2] = (float)((w.y >> 16) & 0xffu); b[3] = (float)(w.y >> 24); }

template <int MODE> struct Epi {
    static constexpr bool PERM = true, AFTER_DRAIN = false, MIDK = (MODE == EPI_MERGE2);
    unsigned char* ws;
    const float* src;
    float* dstf;
    bf16_t* dstb;
    const bf16_t* gates;
    const float* bias;
    float alpha;
    float* ssq;
    unsigned* cnt;
    const float* gain;
    const bf16_t* srcb;
    const bf16_t* pe;
    const float* rs;
    __device__ __forceinline__ void mid(f32x4 (&acc)[2][2][4][2], const Unit& u, int wr, int wc, int fr, int fq) const {
        int rbase = u.pm * BM + wr * 64 + fr; asm volatile("" : "+v"(rbase));
        const unsigned cw = (unsigned)(u.pn * BM + wc * 32 + 8 * fq);
#pragma unroll
        for (int ai = 0; ai < 2; ++ai)
#pragma unroll
            for (int m = 0; m < 4; ++m) { const unsigned ro = (unsigned)(rbase + ai * HALF + m * 16) * 4096u + cw;
#pragma unroll
                for (int bj = 0; bj < 2; ++bj) {
                    const unsigned char* g8 = (const unsigned char*)gates;
                    f32x4 f0, f1, g0, g1; unpack8u8(__builtin_nontemporal_load((const u32x2*)(g8 + (ro + bj * HALF))), f0, f1); unpack8u8(*(const u32x2*)(g8 + (ro + 2048u + bj * HALF)), g0, g1);
#pragma unroll
                    for (int i = 0; i < 4; ++i) { acc[ai][bj][m][0][i] *= f0[i] * __builtin_amdgcn_rcpf(g0[i]); acc[ai][bj][m][1][i] *= f1[i] * __builtin_amdgcn_rcpf(g1[i]); } }
                asm volatile("" ::: "memory"); }
    }
    __device__ __forceinline__ void operator()(const f32x4 (&acc)[2][2][4][2], const Unit& u, int wr, int wc, int fr, int fq) const {
        const int row0 = u.pm * BM + wr * 64 + fr, cw = wc * 32 + 8 * fq;
        if constexpr (MODE == EPI_SWIGLU) {
#pragma unroll
            for (int ai = 0; ai < 2; ++ai)
#pragma unroll
                for (int m = 0; m < 4; ++m) { const size_t row = (size_t)(row0 + ai * HALF + m * 16);
                    const float rstd = rs ? __builtin_amdgcn_rsqf(rs[row] * (1.0f / DM) + EPS) : 1.0f;
                    const f32x4 a = silu4(acc[ai][0][m][0] * rstd) * (acc[ai][1][m][0] * rstd), b = silu4(acc[ai][0][m][1] * rstd) * (acc[ai][1][m][1] * rstd);
                    *(u32x4*)(dstb + row * DFF + u.pn * 128 + cw) = pack8bf(a, b); }
        } else if constexpr (MODE == EPI_P4) {
            const int pn = u.pn;
#pragma unroll
            for (int bj = 0; bj < 2; ++bj) {
                f32x4 bv0 = {0.f, 0.f, 0.f, 0.f}, bv1 = {0.f, 0.f, 0.f, 0.f};
                if (pn >= 24) { const float* bp = bias + (pn - 24) * 256 + bj * HALF + cw; bv0 = *(const f32x4*)bp; bv1 = *(const f32x4*)(bp + 4); }
#pragma unroll
                for (int ai = 0; ai < 2; ++ai)
#pragma unroll
                    for (int m = 0; m < 4; ++m) { const int row = row0 + ai * HALF + m * 16; const float rstd = __builtin_amdgcn_rsqf(rs[row] * (1.0f / DM) + EPS); f32x4 a = acc[ai][bj][m][0] * rstd, b = acc[ai][bj][m][1] * rstd; bf16_t* p;
                        if (pn < 12) { const int which = pn >> 2, head = (pn & 3) * 2 + bj, bb = row >> 12, s = row & 4095;
                            p = (bf16_t*)(ws + WS_FQ) + (size_t)which * T * 1024 + ((size_t)(bb * FOXH + head) * SEQ + s) * HD + cw; }
                        else if (pn < 14) p = (bf16_t*)(ws + WS_GQ) + (size_t)row * 512 + (pn - 12) * 256 + bj * HALF + cw;
                        else if (pn < 16) p = (bf16_t*)(ws + WS_GK) + (size_t)row * 512 + (pn - 14) * 256 + bj * HALF + cw;
                        else if (pn < 20) p = (bf16_t*)(ws + WS_GV) + (size_t)row * 1024 + (pn - 16) * 256 + bj * HALF + cw;
                        else if (pn < 24) { p = (bf16_t*)(ws + WS_SGR) + (size_t)row * 1024 + (pn - 20) * 256 + bj * HALF + cw; a = silu4(a); b = silu4(b); }
                        else { p = nullptr; a = sig4(a + bv0); b = sig4(b + bv1);
                            *(u32x2*)((unsigned char*)(ws + WS_GATES) + (size_t)row * 4096 + (pn - 24) * 256 + bj * HALF + cw) = pack8u8(a, b); }
                        if (p) *(u32x4*)p = pack8bf(a, b); }
            }
        } else if constexpr (MODE == EPI_FINAL) {
            f32x4 (&A)[2][2][4][2] = const_cast<f32x4 (&)[2][2][4][2]>(acc);
#pragma unroll
            for (int ai = 0; ai < 2; ++ai)
#pragma unroll
                for (int m = 0; m < 4; ++m) { const size_t row = (size_t)(row0 + ai * HALF + m * 16);
                    const float rstd = __builtin_amdgcn_rsqf(rs[row] * (1.0f / DM) + EPS); float sq = 0.f;
#pragma unroll
                    for (int bj = 0; bj < 2; ++bj) { const int col = u.pn * BM + bj * HALF + cw; const size_t off = row * DM + col;
                        f32x4 p0, p1, r0, r1; unpack8bf(__builtin_nontemporal_load((const u32x4*)(pe + off)), p0, p1); unpack8bf(*(const u32x4*)(srcb + off), r0, r1);
                        const f32x4 h0 = r0 + sig4(A[ai][bj][m][0] * rstd) * p0, h1 = r1 + sig4(A[ai][bj][m][1] * rstd) * p1;
                        A[ai][bj][m][0] = h0; A[ai][bj][m][1] = h1;
                        sq += (h0[0] * h0[0] + h0[1] * h0[1]) + (h0[2] * h0[2] + h0[3] * h0[3]) + (h1[0] * h1[0] + h1[1] * h1[1]) + (h1[2] * h1[2] + h1[3] * h1[3]); }
                    sq += __shfl_xor(sq, 16); sq += __shfl_xor(sq, 32);
                    if (fq == 0) (void)__hip_atomic_fetch_add(ssq + row, sq, __ATOMIC_RELAXED, __HIP_MEMORY_SCOPE_AGENT); }
            asm volatile("s_waitcnt vmcnt(0)" ::: "memory");
            unsigned* c = cnt + 64 * u.pm;
            if (fr == 0 && fq == 0) (void)__hip_atomic_fetch_add(c, 1u, __ATOMIC_RELAXED, __HIP_MEMORY_SCOPE_AGENT);
            { unsigned sp = 0; const unsigned want = 8u * (unsigned)(DM / BM);
              while ((unsigned)__builtin_amdgcn_readfirstlane(__hip_atomic_load(c, __ATOMIC_RELAXED, __HIP_MEMORY_SCOPE_AGENT)) < want) { __builtin_amdgcn_s_sleep(2); if (++sp > (1u << 22)) break; } }
            asm volatile("" ::: "memory");
#pragma unroll
            for (int ai = 0; ai < 2; ++ai)
#pragma unroll
                for (int m = 0; m < 4; ++m) { const size_t row = (size_t)(row0 + ai * HALF + m * 16);
                    const float tot = __hip_atomic_load(ssq + row, __ATOMIC_RELAXED, __HIP_MEMORY_SCOPE_AGENT);
                    const float rn = __builtin_amdgcn_rsqf(tot * (1.0f / DM) + EPS);
#pragma unroll
                    for (int bj = 0; bj < 2; ++bj) { const int col = u.pn * BM + bj * HALF + cw; const size_t off = row * DM + col;
                        const f32x4 g0 = *(const f32x4*)(gain + col), g1 = *(const f32x4*)(gain + col + 4);
                        __builtin_nontemporal_store(A[ai][bj][m][0] * rn * g0, (f32x4*)(dstf + off)); __builtin_nontemporal_store(A[ai][bj][m][1] * rn * g1, (f32x4*)(dstf + off + 4)); } }
        } else {
#pragma unroll
            for (int ai = 0; ai < 2; ++ai)
#pragma unroll
                for (int m = 0; m < 4; ++m) { const size_t row = (size_t)(row0 + ai * HALF + m * 16);
                    float sq = 0.f; float rstd = 1.0f;
                    if constexpr (MODE == EPI_PLE) rstd = __builtin_amdgcn_rsqf(rs[row] * (1.0f / DM) + EPS);
#pragma unroll
                    for (int bj = 0; bj < 2; ++bj) { const int col = u.pn * BM + bj * HALF + cw; const size_t off = row * DM + col;
                        f32x4 a = acc[ai][bj][m][0], b = acc[ai][bj][m][1];
                        if constexpr (MODE == EPI_RES) { f32x4 s0, s1;
                            if (srcb) unpack8bf(__builtin_nontemporal_load((const u32x4*)(srcb + off)), s0, s1); else { s0 = *(const f32x4*)(src + off); s1 = *(const f32x4*)(src + off + 4); }
                            const f32x4 h0 = s0 + alpha * a, h1 = s1 + alpha * b;
                            if (dstf) { *(f32x4*)(dstf + off) = h0; *(f32x4*)(dstf + off + 4) = h1; }
                            if (dstb) { *(u32x4*)(dstb + off) = pack8bf(h0, h1);
                                sq += (h0[0] * h0[0] + h0[1] * h0[1]) + (h0[2] * h0[2] + h0[3] * h0[3]) + (h1[0] * h1[0] + h1[1] * h1[1]) + (h1[2] * h1[2] + h1[3] * h1[3]); } }
                        else if constexpr (MODE == EPI_Z1) { f32x4 g0, g1; unpack8bf(*(const u32x4*)(gates + row * 4096 + col), g0, g1);
                            *(f32x4*)(dstf + off) = g0 * a; *(f32x4*)(dstf + off + 4) = g1 * b; }
                        else if constexpr (MODE == EPI_MERGE) { f32x4 g0, g1; unpack8bf(*(const u32x4*)(gates + row * 4096 + 2048 + col), g0, g1);
                            const f32x4 z0 = *(const f32x4*)(src + off), z1 = *(const f32x4*)(src + off + 4);
                            *(u32x4*)(dstb + off) = pack8bf(z0 + g0 * a, z1 + g1 * b); }
                        else if constexpr (MODE == EPI_MERGE2) { f32x4 g0, g1; unpack8u8(__builtin_nontemporal_load((const u32x2*)((const unsigned char*)gates + row * 4096 + 2048 + col)), g0, g1);
                            *(u32x4*)(dstb + off) = pack8bf(g0 * (a * (1.0f / 255.0f)), g1 * (b * (1.0f / 255.0f))); }
                        else if constexpr (MODE == EPI_PLE) { f32x4 p0, p1, h0, h1; unpack8bf(*(const u32x4*)(pe + off), p0, p1); unpack8bf(*(const u32x4*)(srcb + off), h0, h1);
                            *(f32x4*)(dstf + off) = h0 + sig4(a * rstd) * p0; *(f32x4*)(dstf + off + 4) = h1 + sig4(b * rstd) * p1; }
                        else { *(u32x4*)(dstb + off) = pack8bf(a, b); }
                    }
                    if constexpr (MODE == EPI_RES) { if (dstb) { sq += __shfl_xor(sq, 16); sq += __shfl_xor(sq, 32); if (fq == 0) (void)__hip_atomic_fetch_add(ssq + row, sq, __ATOMIC_RELAXED, __HIP_MEMORY_SCOPE_AGENT);   } }
                }
        }
    }
};
}

namespace fox {
constexpr int D = 128, NW = 8, QBLK = 32, KVBLK = 64, QB = NW * QBLK;
constexpr int SHM_V = KVBLK * D * 2, SHM_K = KVBLK * D * 2;
constexpr int LDS_WSF = 2 * SHM_V + 2 * SHM_K, LDS_F = LDS_WSF + NW * 64 * 4, LDS_END = LDS_F + SEQ * 4;
constexpr int OST = 2048;
constexpr float SCALE = 0.08838834764831845f;
constexpr float THR = 8.f;
using bf16 = __hip_bfloat16;
typedef short bf16x8 __attribute__((ext_vector_type(8)));
typedef short s16x4 __attribute__((ext_vector_type(4)));
typedef float f32x16 __attribute__((ext_vector_type(16)));
typedef float f32x4 __attribute__((ext_vector_type(4)));
typedef unsigned u32x4 __attribute__((ext_vector_type(4)));

#define KSWZ(row, colB) ((row) * 256 + ((colB) ^ (((row) & 7) << 4)))
#define SBAR() __builtin_amdgcn_sched_barrier(0)
__device__ __forceinline__ int v_st(int k, int c) { const int kk = (k & ~0xC) | ((k & 4) << 1) | ((k & 8) >> 1); return ((kk >> 3) * 4 + (c >> 5)) * 512 + ((kk & 7) * 32 + (c & 31)) * 2; }
__device__ __forceinline__ int v_rd_base(int lane) { return ((lane & 3) << 3) | (((lane >> 2) & 3) << 6) | (((lane >> 4) & 1) << 5) | (((lane >> 5) & 1) << 8); }
constexpr int v_rd_off(int d0, int ks, int half) { return d0 * 512 + ks * 4096 + half * 2048; }
__device__ __forceinline__ int crow(int r, int hi) { return (r & 3) + 8 * (r >> 2) + 4 * hi; }
__device__ __forceinline__ unsigned cvtpk(float lo, float hi) { unsigned r; asm volatile("v_cvt_pk_bf16_f32 %0, %1, %2" : "=v"(r) : "v"(lo), "v"(hi)); return r; }
__device__ __forceinline__ bf16x8 load8(const bf16* p) { return *reinterpret_cast<const bf16x8*>(p); }
__device__ __forceinline__ void mask_tile(f32x16& p0, f32x16& p1, int dq, unsigned W) {
    const float NEG = -__builtin_inff();
#pragma unroll
    for (int r = 0; r < 16; ++r) {
        const int c = (r & 3) + 8 * (r >> 2);
        if ((unsigned)(dq - c) >= W) p0[r] = NEG;
        if ((unsigned)(dq - c - 32) >= W) p1[r] = NEG;
    }
}
__device__ __forceinline__ void bias_tile(f32x16& p0, f32x16& p1, const float* fk) {
#pragma unroll
    for (int j = 0; j < 4; ++j) { const f32x4 a = *(const f32x4*)(fk + 8 * j), b = *(const f32x4*)(fk + 32 + 8 * j);
#pragma unroll
        for (int i = 0; i < 4; ++i) { p0[4 * j + i] -= a[i]; p1[4 * j + i] -= b[i]; }
        SBAR(); }
}
__device__ __forceinline__ void partialSM(f32x16& p0, f32x16& p1, float& m_reg, float& mn, float& alpha) {
    float pmax = p0[0]; for (int r = 1; r < 16; ++r) pmax = fmaxf(pmax, p0[r]); for (int r = 0; r < 16; ++r) pmax = fmaxf(pmax, p1[r]);
    { auto rr = __builtin_amdgcn_permlane32_swap(__float_as_uint(pmax), __float_as_uint(pmax), false, false);
      pmax = fmaxf(__uint_as_float(rr[0]), __uint_as_float(rr[1])); }
    constexpr float C2 = 1.4426950408889634f * SCALE;
    if (__builtin_expect(__all((pmax - m_reg) * SCALE <= THR), 1)) { mn = m_reg; alpha = 1.f; }
    else { mn = fmaxf(m_reg, pmax); alpha = __builtin_amdgcn_exp2f((m_reg - mn) * C2); m_reg = mn; }
    const float mnL = -mn * C2;
    for (int r = 0; r < 16; ++r) p0[r] = fmaf(p0[r], C2, mnL); for (int r = 0; r < 16; ++r) p1[r] = fmaf(p1[r], C2, mnL);
    for (int r = 0; r < 16; ++r) p0[r] = __builtin_amdgcn_exp2f(p0[r]);
}
__device__ __forceinline__ void finishSM(f32x16& p0, f32x16& p1, float alpha, float& l_reg, bf16x8& pa0, bf16x8& pa1, bf16x8& pa2, bf16x8& pa3) {
    for (int r = 0; r < 16; ++r) p1[r] = __builtin_amdgcn_exp2f(p1[r]);
    float ps = 0; for (int r = 0; r < 16; ++r) ps += p0[r]; for (int r = 0; r < 16; ++r) ps += p1[r];
    { auto rr = __builtin_amdgcn_permlane32_swap(__float_as_uint(ps), __float_as_uint(ps), false, false);
      ps = __uint_as_float(rr[0]) + __uint_as_float(rr[1]); }
    l_reg = l_reg * alpha + ps;
#define PK4(P, B_, OUT) do { unsigned a0 = cvtpk(P[B_+0], P[B_+1]), a1 = cvtpk(P[B_+2], P[B_+3]);                          \
        unsigned b0 = cvtpk(P[B_+4], P[B_+5]), b1 = cvtpk(P[B_+6], P[B_+7]);                                             \
        auto r0 = __builtin_amdgcn_permlane32_swap(a0, b0, false, false); auto r1 = __builtin_amdgcn_permlane32_swap(a1, b1, false, false); \
        u32x4 w = {r0[0], r1[0], r0[1], r1[1]}; OUT = *reinterpret_cast<bf16x8*>(&w); } while (0)
    PK4(p0, 0, pa0); PK4(p0, 8, pa1); PK4(p1, 0, pa2); PK4(p1, 8, pa3);
#undef PK4
}
template <int KB>
__device__ __forceinline__ void qkt(f32x16& p0, f32x16& p1, const char* K_lds, int r32, int hi, const bf16x8* qr) {
    p0 = f32x16{}; p1 = f32x16{};
    const char* kb[4];
#pragma unroll
    for (int dd = 0; dd < 4; ++dd) kb[dd] = K_lds + KB * SHM_K + KSWZ(r32, (dd * 16 + hi * 8) * 2);
#pragma unroll
    for (int d0 = 0; d0 < 8; ++d0) { const char* a = kb[d0 & 3] + (d0 >> 2) * 128;
        bf16x8 b0 = *reinterpret_cast<const bf16x8*>(a);
        bf16x8 b1 = *reinterpret_cast<const bf16x8*>(a + 32 * 256);
        p0 = __builtin_amdgcn_mfma_f32_32x32x16_bf16(b0, qr[d0], p0, 0, 0, 0);
        p1 = __builtin_amdgcn_mfma_f32_32x32x16_bf16(b1, qr[d0], p1, 0, 0, 0); }
}
template <int VB>
__device__ __forceinline__ void pv_tile(f32x16* o, int vb0, bf16x8 pa0, bf16x8 pa1, bf16x8 pa2, bf16x8 pa3) {
#define TRRD(dst, off) asm volatile("ds_read_b64_tr_b16 %0, %1 offset:%2" : "=&v"(dst) : "v"(vb0), "i"(off) : "memory")
#define PV_D0(d0) do { s16x4 l0, l1, l2, l3, h0, h1, h2, h3; constexpr int b_ = VB * SHM_V + v_rd_off(d0, 0, 0); \
        TRRD(l0, b_); TRRD(h0, b_ + 2048); TRRD(l1, b_ + 4096); TRRD(h1, b_ + 6144); TRRD(l2, b_ + 8192); TRRD(h2, b_ + 10240); TRRD(l3, b_ + 12288); TRRD(h3, b_ + 14336); \
        asm volatile("s_waitcnt lgkmcnt(0)" ::: "memory"); SBAR(); \
        o[d0] = __builtin_amdgcn_mfma_f32_32x32x16_bf16(pa0, (bf16x8){l0[0], l0[1], l0[2], l0[3], h0[0], h0[1], h0[2], h0[3]}, o[d0], 0, 0, 0);   \
        o[d0] = __builtin_amdgcn_mfma_f32_32x32x16_bf16(pa1, (bf16x8){l1[0], l1[1], l1[2], l1[3], h1[0], h1[1], h1[2], h1[3]}, o[d0], 0, 0, 0);   \
        o[d0] = __builtin_amdgcn_mfma_f32_32x32x16_bf16(pa2, (bf16x8){l2[0], l2[1], l2[2], l2[3], h2[0], h2[1], h2[2], h2[3]}, o[d0], 0, 0, 0);   \
        o[d0] = __builtin_amdgcn_mfma_f32_32x32x16_bf16(pa3, (bf16x8){l3[0], l3[1], l3[2], l3[3], h3[0], h3[1], h3[2], h3[3]}, o[d0], 0, 0, 0); } while (0)
    PV_D0(0); PV_D0(1); PV_D0(2); PV_D0(3);
#undef PV_D0
#undef TRRD
}

struct BlockRef { const bf16* Q; const bf16* K; const bf16* V; bf16* O; int P0; };
struct Seam { bf16x8 qr[8]; bf16x8 st_v0, st_v1, st_k0, st_k1; };
#define ROW(p, k0, rr) (((p) + (size_t)((k0) + (rr) - sr) * D) + toff)
#define VMW() asm volatile("s_waitcnt vmcnt(0)" ::: "memory")
#define VMWN(n) asm volatile("s_waitcnt vmcnt(%0)" :: "i"(n) : "memory")
#define SLOAD_H(Kp, Vp, k0) do { S.st_v0 = load8(ROW(Vp, k0, sr)); S.st_v1 = load8(ROW(Vp, k0, 32 + sr));              \
                         S.st_k0 = load8(ROW(Kp, k0, sr)); S.st_k1 = load8(ROW(Kp, k0, 32 + sr)); } while (0)
#define SWRITE_HK(bf) do { *(bf16x8*)(K_lds + (bf) * SHM_K + kws) = S.st_k0; *(bf16x8*)(K_lds + (bf) * SHM_K + kws + 32 * 256) = S.st_k1; } while (0)
#define SWRITE_HV(bf) do { *(bf16x8*)(V_lds + (bf) * SHM_V + vst0) = S.st_v0; *(bf16x8*)(V_lds + (bf) * SHM_V + vst1) = S.st_v1; } while (0)
#define SWRITE_H(bf) do { SWRITE_HV(bf); SWRITE_HK(bf); } while (0)
__device__ __forceinline__ void causal_prime(const BlockRef& cur, char* lds, Seam& S) {
    const int tid = opaque_tid(), wid = __builtin_amdgcn_readfirstlane(tid >> 6), lane = tid & 63, r32 = lane & 31, hi = lane >> 5;
    const int sr = tid >> 4, sc = (tid & 15) * 8, kws = KSWZ(sr, sc * 2); const unsigned toff = (unsigned)(sr * D + sc); char* K_lds = lds + 2 * SHM_V;
    for (int d0 = 0; d0 < 8; ++d0) S.qr[d0] = load8(cur.Q + (size_t)(wid * QBLK + r32) * D + d0 * 16 + hi * 8);
    SLOAD_H(cur.K, cur.V, 0); VMW(); SWRITE_HK(0);
    __syncthreads();
}
__device__ __forceinline__ void causal_block(const BlockRef& cur, const BlockRef& nxt, char* lds, Seam& S) {
    const int tid = opaque_tid(), wid = __builtin_amdgcn_readfirstlane(tid >> 6), lane = tid & 63, r32 = lane & 31, hi = lane >> 5;
    constexpr unsigned W = 0x40000000u;
    const int NT = (cur.P0 + QB - 1) / KVBLK + 1;
    const int qlo = cur.P0 + wid * QBLK, qm = qlo + r32 - 4 * hi;
    char* V_lds = lds; char* K_lds = lds + 2 * SHM_V;
    float* ws = (float*)(lds + LDS_WSF) + wid * 64; float* li_l = ws, * al_l = ws + 32;
    float* Fl = (float*)(lds + LDS_F);
    const float* Fk0 = Fl + 4 * hi;
    float m_reg = -1e30f, l_reg = 0; f32x16 o[4] = {};
    const int sr = tid >> 4, sc = (tid & 15) * 8, vst0 = v_st(sr, sc), vst1 = v_st(32 + sr, sc), kws = KSWZ(sr, sc * 2); const unsigned toff = (unsigned)(sr * D + sc);
    const int vb0 = (int)(uintptr_t)V_lds + v_rd_base(lane);
    const bf16* Kh = cur.K; const bf16* Vh = cur.V;
#define RESC(a) do { if (__any((a) < 1.f)) { if (hi == 0) al_l[r32] = (a); asm volatile("s_waitcnt lgkmcnt(0)" ::: "memory");              \
                     for (int d_ = 0; d_ < 4; ++d_) for (int r = 0; r < 16; ++r) o[d_][r] *= al_l[crow(r, hi)]; } } while (0)
#define KBASE(t) ((t) * KVBLK)
#define MASKT(P0_, P1_, t) do { const int kb_ = KBASE(t); bias_tile(P0_, P1_, Fk0 + kb_); if (kb_ + KVBLK - 1 > qlo) mask_tile(P0_, P1_, qm - kb_, W); } while (0)
    constexpr int NQL = 8;
#define SEAM_K0() do { VMWN(NQL); SWRITE_HK(0); SBAR(); } while (0)
    f32x16 pA0, pA1, pB0, pB1; float mnA, mnB, alA, alB; bf16x8 pa0, pa1, pa2, pa3;
    SWRITE_HV(0); SBAR();
    if (NT > 1) { SLOAD_H(Kh, Vh, KBASE(1)); }
    SBAR(); qkt<0>(pA0, pA1, K_lds, r32, hi, S.qr);
    MASKT(pA0, pA1, 0); partialSM(pA0, pA1, m_reg, mnA, alA);
    if (NT > 1) { VMW(); SWRITE_H(1); }
    __syncthreads();
#define HALF_STEP(PX0, PX1, mnX, alX, PY0, PY1, alY, t, KB, VB, SB) do {                                                      \
        SBAR(); qkt<KB>(PX0, PX1, K_lds, r32, hi, S.qr);                                             \
        finishSM(PY0, PY1, alY, l_reg, pa0, pa1, pa2, pa3); SBAR();                                                           \
        if ((t) + 1 < NT) { SLOAD_H(Kh, Vh, KBASE((t) + 1)); SBAR(); }                                               \
        pv_tile<VB>(o, vb0, pa0, pa1, pa2, pa3); MASKT(PX0, PX1, (t)); partialSM(PX0, PX1, m_reg, mnX, alX);                                        \
        __syncthreads();                                                                                                      \
        if ((t) + 1 < NT) { VMW(); SWRITE_H(SB); }                                                                          \
        RESC(alX); __syncthreads(); } while (0)
    for (int t = 1; t + 1 < NT; t += 2) {
        HALF_STEP(pB0, pB1, mnB, alB, pA0, pA1, alA, t, 1, 0, 0);
        HALF_STEP(pA0, pA1, mnA, alA, pB0, pB1, alB, t + 1, 0, 1, 1);
    }
    const bool even = (NT & 1) == 0;
    if (even) { SBAR(); qkt<1>(pB0, pB1, K_lds, r32, hi, S.qr); SBAR(); }
    SLOAD_H(nxt.K, nxt.V, 0); SBAR();
#pragma unroll
    for (int d0 = 0; d0 < 8; ++d0) S.qr[d0] = load8(nxt.Q + (size_t)(wid * QBLK + r32) * D + d0 * 16 + hi * 8);
    SBAR();
    finishSM(pA0, pA1, alA, l_reg, pa0, pa1, pa2, pa3); SBAR();
    pv_tile<0>(o, vb0, pa0, pa1, pa2, pa3);
    if (even) { MASKT(pB0, pB1, NT - 1); partialSM(pB0, pB1, m_reg, mnB, alB); __syncthreads(); RESC(alB);
        finishSM(pB0, pB1, alB, l_reg, pa0, pa1, pa2, pa3); SBAR(); pv_tile<1>(o, vb0, pa0, pa1, pa2, pa3); }
    SBAR(); SEAM_K0();
    if (hi == 0) li_l[r32] = l_reg; asm volatile("s_waitcnt lgkmcnt(0)" ::: "memory");
    float rli[16];
#pragma unroll
    for (int r = 0; r < 16; ++r) rli[r] = __builtin_amdgcn_rcpf(li_l[crow(r, hi)]);
    bf16* Ow = cur.O + (size_t)(wid * QBLK) * OST;
#pragma unroll
    for (int r = 0; r < 16; ++r) { const int orow = crow(r, hi);
#pragma unroll
        for (int d0 = 0; d0 < 4; ++d0) { const float v = o[d0][r] * rli[r];
            const float vn = __shfl_xor(v, 1);
            if ((r32 & 1) == 0) *(unsigned*)(Ow + (size_t)orow * OST + d0 * 32 + r32) = cvtpk(v, vn); } }
    __syncthreads();
#undef RESC
#undef KBASE
#undef MASKT
#undef SEAM_K0
#undef HALF_STEP
}
#undef ROW
#undef VMW
#undef VMWN
#undef SLOAD_H
#undef SWRITE_HK
#undef SWRITE_HV
#undef SWRITE_H

__device__ __forceinline__ void fcumsum_lds(const unsigned char* ws, float* Fl, float* scr, int bh, int tid) {
    const int b = bh >> 3, h = bh & 7, lane = tid & 63, wave = tid >> 6;
    const float* lf = (const float*)(ws + WS_LF) + (size_t)b * SEQ * 8 + h;
    float v[8]; float s = 0.f;
#pragma unroll
    for (int i = 0; i < 8; ++i) { s += lf[(size_t)(tid * 8 + i) * 8]; v[i] = s; }
    float incl = s;
#pragma unroll
    for (int o = 1; o < 64; o <<= 1) { const float t = __shfl_up(incl, o); if (lane >= o) incl += t; }
    __syncthreads();
    if (lane == 63) scr[wave] = incl;
    __syncthreads();
    float pre = incl - s;
    for (int w = 0; w < wave; ++w) pre += scr[w];
    const float isc = 11.313708498984761f;
#pragma unroll
    for (int i = 0; i < 8; ++i) Fl[tid * 8 + i] = (pre + v[i]) * isc;
    __syncthreads();
}

__device__ __forceinline__ BlockRef make_ref(int bh, int qb, const unsigned char* ws_c, unsigned char* ws) {
    BlockRef r; const int b = bh >> 3, h = bh & 7;
    const size_t off = ((size_t)bh * SEQ + (size_t)qb * QB) * D;
    r.Q = (const bf16*)(ws_c + WS_FQ) + off; r.K = (const bf16*)(ws_c + WS_FK) + (size_t)bh * SEQ * D; r.V = (const bf16*)(ws_c + WS_FV) + (size_t)bh * SEQ * D;
    r.O = (bf16*)(ws + WS_YF) + ((size_t)(b * SEQ + qb * QB)) * OST + h * D;
    r.P0 = qb * QB; return r;
}
__device__ __forceinline__ void attn_phase(char* lds, unsigned char* ws, int first, int stride) {
    constexpr int NITEMS = 128;
    int L = first; if (L >= NITEMS) return;
    int bh = L >> 3, x = L & 7, pass = 0;
    BlockRef cur = make_ref(bh, x, ws, ws);
    Seam S;
    causal_prime(cur, lds, S);
    int bh_cur = bh, bh_loaded = -1;
    for (;;) {
        if (bh_cur != bh_loaded) { fcumsum_lds(ws, (float*)(lds + LDS_F), (float*)(lds + LDS_AUX), bh_cur, (int)threadIdx.x); bh_loaded = bh_cur; }
        const bool more_pass = pass == 0, more_item = L + stride < NITEMS, last = !more_pass && !more_item;
        int Ln = L, passn = pass + 1;
        if (!more_pass) { passn = 0; Ln = more_item ? L + stride : L; }
        const int bhn = Ln >> 3, xn = Ln & 7, qbn = passn ? 15 - xn : xn;
        const BlockRef nxt = last ? cur : make_ref(bhn, qbn, ws, ws);
        causal_block(cur, nxt, lds, S);
        if (last) break;
        cur = nxt; pass = passn; L = Ln; bh_cur = bhn;
    }
}
#undef KSWZ
#undef SBAR
}

#define LAS __attribute__((address_space(3)))
typedef unsigned short bf16;
typedef unsigned v4u __attribute__((ext_vector_type(4)));
typedef unsigned v2u __attribute__((ext_vector_type(2)));
typedef float f32x4 __attribute__((ext_vector_type(4)));
typedef float f32x2 __attribute__((ext_vector_type(2)));
typedef short bf16x8 __attribute__((ext_vector_type(8)));

constexpr int TR_SLOT = 16896;
struct TrDesc { const float* W; bf16* WT; const float* gain; int K, ld, c0, nblk, row0, sw, item, valid, dK, dk0; };
__device__ __forceinline__ void tr_load(const TrDesc& d, f32x4 (&v)[16], int lane) {
    const int kb = d.item / d.nblk, nb = d.item % d.nblk, k0 = 64 * kb, n0 = 64 * nb, q = lane >> 4, l15 = lane & 15;
    const float* src = d.W + (size_t)(k0 + q) * d.ld + d.c0 + n0 + 4 * l15;
#pragma unroll
    for (int i = 0; i < 16; ++i) v[i] = __builtin_nontemporal_load((const f32x4*)(src + (size_t)(4 * i) * d.ld));
}
__device__ __forceinline__ void tr_process(const TrDesc& d, f32x4 (&v)[16], float* scr, int lane) {
    const int kb = d.item / d.nblk, nb = d.item % d.nblk, k0 = 64 * kb, n0 = 64 * nb, q = lane >> 4, l15 = lane & 15;
    if (d.gain) {
#pragma unroll
        for (int i = 0; i < 16; ++i) v[i] = v[i] * d.gain[k0 + 4 * i + q];
    }
#pragma unroll
    for (int i = 0; i < 16; ++i) { float* p = scr + (4 * i + q) * 65 + 4 * l15; p[0] = v[i].x; p[1] = v[i].y; p[2] = v[i].z; p[3] = v[i].w; }
    asm volatile("s_waitcnt lgkmcnt(0)" ::: "memory");
    const int c = lane & 7;
    const int drow0 = d.sw ? (256 * (n0 >> 7) + 128 * (d.sw - 1) + (n0 & 127)) : (d.row0 + n0);
#pragma unroll
    for (int j = 0; j < 8; ++j) { const int n = (lane >> 3) + 8 * j; const float* s = scr + (8 * c) * 65 + n;
        v4u o; o.x = pk2(s[0 * 65], s[1 * 65]); o.y = pk2(s[2 * 65], s[3 * 65]); o.z = pk2(s[4 * 65], s[5 * 65]); o.w = pk2(s[6 * 65], s[7 * 65]);
        *(v4u*)(d.WT + (size_t)(drow0 + n) * d.dK + d.dk0 + k0 + 8 * c) = o; }
    asm volatile("s_waitcnt lgkmcnt(0)" ::: "memory");
}

template <bool OUTF32>
__device__ __forceinline__ void rms_row(const float* xrow, const float* gain, void* orow, int lane) {
    const f32x4* xr = (const f32x4*)xrow + lane;
    f32x4 v[8]; float s = 0.f;
#pragma unroll
    for (int j = 0; j < 8; ++j) { v[j] = xr[64 * j]; s += (v[j].x * v[j].x + v[j].y * v[j].y) + (v[j].z * v[j].z + v[j].w * v[j].w); }
    const float rstd = __builtin_amdgcn_rsqf(wave_sum(s) * (1.0f / DM) + EPS);
#pragma unroll
    for (int j = 0; j < 8; ++j) { const f32x4 g = ((const f32x4*)gain)[lane + 64 * j]; const f32x4 y = v[j] * rstd * g;
        if constexpr (OUTF32) ((f32x4*)orow)[lane + 64 * j] = y;
        else { v2u w; w.x = pk2(y.x, y.y); w.y = pk2(y.z, y.w); ((v2u*)orow)[lane + 64 * j] = w; } }
}

template <int SET>
__device__ __forceinline__ TrDesc tr_resolve(const Args& a, int it) {
    unsigned char* ws = a.ws; TrDesc d; d.valid = 0; d.W = nullptr; d.WT = nullptr; d.gain = nullptr; d.K = d.ld = d.c0 = d.nblk = d.row0 = d.sw = d.item = d.dK = d.dk0 = 0;
    int r = it;
#define SEG(Wp, K_, LD_, C0_, NC_, DST_, R0_, SW_, GAIN_) if (!d.valid) { constexpr int ni_ = ((K_) / 64) * ((NC_) / 64); if (r < ni_) { d.W = Wp; d.WT = (bf16*)(ws + (DST_)); d.gain = GAIN_; d.K = K_; d.ld = LD_; d.c0 = C0_; d.nblk = (NC_) / 64; d.row0 = R0_; d.sw = SW_; d.item = r; d.valid = 1; d.dK = K_; d.dk0 = 0; } else r -= ni_; }
    if constexpr (SET == 0) {
        SEG(a.in[3], DM, DFF, 0, DFF, WS_WGU1, 0, 1, a.in[2])
        SEG(a.in[4], DM, DFF, 0, DFF, WS_WGU1, 0, 2, a.in[2])
        SEG(a.in[22], PLE, DM, 0, DM, WS_WPE, 0, 0, nullptr)
    } else if constexpr (SET == 1) {
        SEG(a.in[5], DFF, DM, 0, DM, WS_WD1, 0, 0, nullptr)
        SEG(a.in[7], DM, DIN, 0, 3072, WS_W4, 0, 0, a.in[6])
        SEG(a.in[7], DM, DIN, 3080, 3072, WS_W4, 3072, 0, a.in[6])
        SEG(a.in[14], DM, 4096, 0, 4096, WS_W4, 6144, 0, a.in[6])
    } else if constexpr (SET == 3) {
        SEG(a.in[18], DM, DFF, 0, DFF, WS_WGU2, 0, 1, a.in[17])
        SEG(a.in[19], DM, DFF, 0, DFF, WS_WGU2, 0, 2, a.in[17])
        SEG(a.in[12], 1024, DM, 0, DM, WS_WA, 0, 0, nullptr) if (d.valid && d.W == a.in[12]) { d.dK = 2048; }
        SEG(a.in[13], 1024, DM, 0, DM, WS_WA, 0, 0, nullptr) if (d.valid && d.W == a.in[13]) { d.dK = 2048; d.dk0 = 1024; }
        SEG(a.in[16], DM, DM, 0, DM, WS_WOUT, 0, 0, nullptr)
    } else {
        SEG(a.in[20], DFF, DM, 0, DM, WS_WD2, 0, 0, nullptr)
        SEG(a.in[23], DM, DM, 0, DM, WS_WPG, 0, 0, a.in[21])
    }
#undef SEG
    return d;
}
template <int SET>
__device__ __forceinline__ void convert_set(const Args& a, unsigned char* lds, int w, int NW, int wave, int lane) {
    float* scr = (float*)(lds + wave * TR_SLOT);
    f32x4 vA[16], vB[16];
    int it = w;
    TrDesc dA = tr_resolve<SET>(a, it), dB;
    if (dA.valid) tr_load(dA, vA, lane);
    while (dA.valid) {
        dB = tr_resolve<SET>(a, it + NW); if (dB.valid) tr_load(dB, vB, lane);
        tr_process(dA, vA, scr, lane);
        if (!dB.valid) break;
        it += 2 * NW;
        dA = tr_resolve<SET>(a, it); if (dA.valid) tr_load(dA, vA, lane);
        tr_process(dB, vB, scr, lane);
    }
}
constexpr int NCONV = 21;
__device__ __forceinline__ void p0_prologue(const Args& a, unsigned char* lds, int gw, int NGW, int wave, int lane) {
    unsigned char* ws = a.ws;
    convert_set<0>(a, lds, gw, NGW, wave, lane);
    { float* wsm = (float*)(ws + WS_WSM); const float* win = a.in[7];
        for (int i = gw * 64 + lane; i < 24 * DM; i += NGW * 64) { const int c = i % 24, k = i / 24; wsm[(size_t)c * DM + k] = win[(size_t)k * DIN + (c < 8 ? 3072 + c : 6152 + (c - 8))]; } }
    { float* q = (float*)(ws + WS_SSQ); for (int i = gw * 64 + lane; i < 4 * T; i += NGW * 64) q[i] = 0.f; }
    for (int m = gw; m < T; m += NGW) {
        const f32x4* xr = (const f32x4*)(a.in[0] + (size_t)m * DM) + lane; v2u* o = (v2u*)((bf16*)(ws + WS_XN) + (size_t)m * DM);
        f32x4 v[8]; float sq = 0.f;
#pragma unroll
        for (int j = 0; j < 8; ++j) { v[j] = __builtin_nontemporal_load(xr + 64 * j); sq += (v[j].x * v[j].x + v[j].y * v[j].y) + (v[j].z * v[j].z + v[j].w * v[j].w); }
        sq = wave_sum(sq);
#pragma unroll
        for (int j = 0; j < 8; ++j) { v2u w; w.x = pk2(v[j].x, v[j].y); w.y = pk2(v[j].z, v[j].w); o[lane + 64 * j] = w; }
        if (lane == 0) ((float*)(ws + WS_SSQ))[4 * T + m] = sq;
    }
    { const f32x4* p = (const f32x4*)a.in[1]; v2u* o = (v2u*)(ws + WS_PB);
        for (int i = gw * 64 + lane; i < T * PLE / 4; i += NGW * 64) { const f32x4 v = __builtin_nontemporal_load(p + i); v2u w; w.x = pk2(v.x, v.y); w.y = pk2(v.z, v.w); o[i] = w; } }
}

__device__ __forceinline__ void p3_rows(const Args& a, const float* H, unsigned char* lds, int bx, int G, int tid) {
    constexpr int NR = 4;
    unsigned char* ws = a.ws;
    const int lane = tid & 63, wave = tid >> 6;
    const f32x4* wsm4 = (const f32x4*)(ws + WS_WSM);
    f32x4* wl = (f32x4*)lds;
    f32x4* gul = (f32x4*)(lds + 98304);
    { const f32x4* gu = (const f32x4*)a.in[9];
#pragma unroll
      for (int i = 0; i < 4; ++i) gul[tid + 512 * i] = gu[tid + 512 * i]; }
    for (int it = bx; it < T / (8 * NR); it += G) {
        const int m0 = it * (8 * NR) + wave * NR;
        f32x4 u[NR][8];
#pragma unroll
        for (int r = 0; r < NR; ++r) {
            const v2u* xr = (const v2u*)((const bf16*)H + (size_t)(m0 + r) * DM) + lane; float s = 0.f;
#pragma unroll
            for (int j = 0; j < 8; ++j) { const v2u w = xr[64 * j]; u[r][j] = (f32x4){__builtin_bit_cast(float, w.x << 16), __builtin_bit_cast(float, w.x & 0xffff0000u), __builtin_bit_cast(float, w.y << 16), __builtin_bit_cast(float, w.y & 0xffff0000u)}; s += (u[r][j].x * u[r][j].x + u[r][j].y * u[r][j].y) + (u[r][j].z * u[r][j].z + u[r][j].w * u[r][j].w); }
            const float rstd = __builtin_amdgcn_rsqf(wave_sum(s) * (1.0f / DM) + EPS);
#pragma unroll
            for (int j = 0; j < 8; ++j) { const f32x4 g = ((const f32x4*)a.in[6])[lane + 64 * j]; u[r][j] = u[r][j] * rstd * g; }
        }
        float mine[NR];
#pragma unroll
        for (int r = 0; r < NR; ++r) mine[r] = 0.f;
        for (int half = 0; half < 2; ++half) {
            __syncthreads();
#pragma unroll 4
            for (int i = 0; i < 12; ++i) wl[tid + 512 * i] = wsm4[(size_t)half * 6144 + tid + 512 * i];
            __syncthreads();
            for (int c = 0; c < 12; ++c) {
                const f32x4* wr = wl + c * 512 + lane;
                float d[NR];
#pragma unroll
                for (int r = 0; r < NR; ++r) d[r] = 0.f;
#pragma unroll
                for (int j = 0; j < 8; ++j) { const f32x4 w = wr[64 * j];
#pragma unroll
                    for (int r = 0; r < NR; ++r) d[r] += (u[r][j].x * w.x + u[r][j].y * w.y) + (u[r][j].z * w.z + u[r][j].w * w.w); }
#pragma unroll
                for (int r = 0; r < NR; ++r) d[r] = wave_sum(d[r]);
                if (lane == half * 12 + c) {
#pragma unroll
                    for (int r = 0; r < NR; ++r) mine[r] = d[r]; }
            }
        }
        if (lane < 8) { const float fb = a.in[8][lane]; float* lf = (float*)(ws + WS_LF);
#pragma unroll
            for (int r = 0; r < NR; ++r) lf[(size_t)(m0 + r) * 8 + lane] = logsigmoid_f(mine[r] + fb); }
        { const f32x4 b0 = ((const f32x4*)a.in[10])[lane * 2], b1 = ((const f32x4*)a.in[10])[lane * 2 + 1];
          float* la = (float*)(ws + WS_LA);
#pragma unroll
          for (int rp = 0; rp < NR; rp += 2) {
            f32x4 acc[2][2];
            acc[0][0] = b0; acc[0][1] = b1; acc[1][0] = b0; acc[1][1] = b1;
#pragma unroll
            for (int k = 0; k < RANK; ++k) { const f32x4 g0 = gul[k * 128 + lane * 2], g1 = gul[k * 128 + lane * 2 + 1];
                const float gd0 = __shfl(mine[rp], 8 + k), gd1 = __shfl(mine[rp + 1], 8 + k);
                acc[0][0] += gd0 * g0; acc[0][1] += gd0 * g1; acc[1][0] += gd1 * g0; acc[1][1] += gd1 * g1; }
#pragma unroll
            for (int r = 0; r < 2; ++r) { f32x4 o0, o1;
#pragma unroll
                for (int i = 0; i < 4; ++i) { o0[i] = logsigmoid_f(acc[r][0][i]) * (1.0f / 16.0f); o1[i] = logsigmoid_f(acc[r][1][i]) * (1.0f / 16.0f); }
                ((f32x4*)(la + (size_t)(m0 + rp + r) * 512))[lane * 2] = o0; ((f32x4*)(la + (size_t)(m0 + rp + r) * 512))[lane * 2 + 1] = o1; } } }
    }
    __syncthreads();
}

constexpr int GL_KD = 0, GL_VT = 128 * 144, GL_TOT = GL_VT + 256 * 144, GL_END = GL_TOT + 4 * 128 * 4;
__device__ __forceinline__ void gla_g1(unsigned char* ws, unsigned char* lds, int unit, int tid) {
    const int bh = unit >> 6, c = unit & 63, b = bh >> 2, h = bh & 3, lane = tid & 63, wave = tid >> 6;
    const size_t t0 = (size_t)b * SEQ + (size_t)c * CHUNK;
    {
        const int ch = tid & 127, fg = tid >> 7;
        const float* la = (const float*)(ws + WS_LA) + (t0 + 16 * fg) * 512 + h * 128 + ch;
        const bf16* kp = (const bf16*)(ws + WS_GK) + (t0 + 16 * fg) * 512 + h * 128 + ch;
        const bf16* vp = (const bf16*)(ws + WS_GV) + t0 * 1024 + h * 256;
        float ac[16]; bf16 kr[16]; v4u vw[4];
#pragma unroll
        for (int f = 0; f < 16; ++f) ac[f] = __builtin_nontemporal_load(la + (size_t)f * 512);
#pragma unroll
        for (int f = 0; f < 16; ++f) kr[f] = __builtin_nontemporal_load(kp + (size_t)f * 512);
#pragma unroll
        for (int i = 0; i < 4; ++i) { const int idx = tid + 512 * i, f = idx & 63, v8 = (idx >> 6) * 8; vw[i] = __builtin_nontemporal_load((const v4u*)(vp + (size_t)f * 1024 + v8)); }
        float s = 0.f;
#pragma unroll
        for (int f = 0; f < 16; ++f) { s += ac[f]; ac[f] = s; }
        float* tot = (float*)(lds + GL_TOT);
        tot[fg * 128 + ch] = s;
#pragma unroll
        for (int i = 0; i < 4; ++i) { const int idx = tid + 512 * i, f = idx & 63, v8 = (idx >> 6) * 8; const v4u w = vw[i];
            bf16* d = (bf16*)(lds + GL_VT) + f;
            d[(v8 + 0) * 72] = (bf16)(w.x & 0xffff); d[(v8 + 1) * 72] = (bf16)(w.x >> 16); d[(v8 + 2) * 72] = (bf16)(w.y & 0xffff); d[(v8 + 3) * 72] = (bf16)(w.y >> 16);
            d[(v8 + 4) * 72] = (bf16)(w.z & 0xffff); d[(v8 + 5) * 72] = (bf16)(w.z >> 16); d[(v8 + 6) * 72] = (bf16)(w.w & 0xffff); d[(v8 + 7) * 72] = (bf16)(w.w >> 16); }
        __syncthreads();
        float pre = 0.f, all = 0.f;
#pragma unroll
        for (int g = 0; g < 4; ++g) { const float tg = tot[g * 128 + ch]; all += tg; if (g < fg) pre += tg; }
        if (fg == 0) ((float*)(ws + WS_DEC))[(size_t)unit * 128 + ch] = __expf(all);
        unsigned pk[8];
#pragma unroll
        for (int f = 0; f < 16; f += 2) { const float k0 = bf2f(kr[f]) * __expf(all - (pre + ac[f])), k1 = bf2f(kr[f + 1]) * __expf(all - (pre + ac[f + 1])); pk[f >> 1] = pk2(k0, k1); }
        v4u* dst = (v4u*)(lds + GL_KD + ch * 144 + fg * 32);
        dst[0] = (v4u){pk[0], pk[1], pk[2], pk[3]}; dst[1] = (v4u){pk[4], pk[5], pk[6], pk[7]};
    }
    __syncthreads();
    { const int l15 = lane & 15, quad = lane >> 4;
        bf16x8 af[2][2];
#pragma unroll
        for (int mt = 0; mt < 2; ++mt)
#pragma unroll
            for (int kk = 0; kk < 2; ++kk) af[mt][kk] = *(const bf16x8*)(lds + GL_VT + (32 * wave + 16 * mt + l15) * 144 + kk * 64 + quad * 16);
        float* out = (float*)(ws + WS_KV) + (size_t)unit * 256 * 128;
#pragma unroll
        for (int nt = 0; nt < 8; ++nt) {
            const bf16x8 b0 = *(const bf16x8*)(lds + GL_KD + (16 * nt + l15) * 144 + quad * 16), b1 = *(const bf16x8*)(lds + GL_KD + (16 * nt + l15) * 144 + 64 + quad * 16);
#pragma unroll
            for (int mt = 0; mt < 2; ++mt) { f32x4 acc = {0.f, 0.f, 0.f, 0.f};
                acc = __builtin_amdgcn_mfma_f32_16x16x32_bf16(af[mt][0], b0, acc, 0, 0, 0);
                acc = __builtin_amdgcn_mfma_f32_16x16x32_bf16(af[mt][1], b1, acc, 0, 0, 0);
#pragma unroll
                for (int j = 0; j < 4; ++j) out[(size_t)(32 * wave + 16 * mt + quad * 4 + j) * 128 + 16 * nt + l15] = acc[j]; }
        }
    }
    __syncthreads();
}
__device__ __forceinline__ void gla_g2(unsigned char* ws, int gtid, int gthreads) {
    const float* kv = (const float*)(ws + WS_KV); const float* dec = (const float*)(ws + WS_DEC); bf16* st = (bf16*)(ws + WS_XN);
    for (int e = gtid; e < 8 * 256 * 32; e += gthreads) {
        const int bh = e >> 13, vv = (e >> 5) & 255, ch = (e & 31) * 4;
        const float* kp = kv + ((size_t)bh * 64 * 256 + vv) * 128 + ch; const float* dp = dec + (size_t)bh * 64 * 128 + ch; bf16* sp = st + ((size_t)bh * 64 * 256 + vv) * 128 + ch;
        f32x4 s = {0.f, 0.f, 0.f, 0.f};
#pragma unroll 16
        for (int c = 0; c < NCH; ++c) {
            const f32x4 k = __builtin_nontemporal_load((const f32x4*)(kp + (size_t)c * 256 * 128)), d = *(const f32x4*)(dp + (size_t)c * 128);
            s = d * s + k;
            v2u w; w.x = pk2(s.x, s.y); w.y = pk2(s.z, s.w);
            *(v2u*)(sp + (size_t)c * 256 * 128) = w; }
    }
}
__device__ __forceinline__ void gla_g3(const Args& a, unsigned char* lds, int unit, int tid) {
    unsigned char* ws = a.ws;
    const int bh = unit >> 6, c = unit & 63, b = bh >> 2, h = bh & 3, lane = tid & 63, wave = tid >> 6, l15 = lane & 15, quad = lane >> 4;
    const size_t t0 = (size_t)b * SEQ + (size_t)c * CHUNK;
    const bf16* q = (const bf16*)(ws + WS_GQ) + t0 * 512 + h * 128;
    const bf16* st = (const bf16*)(ws + WS_XN) + (size_t)unit * 256 * 128;
    f32x4 acc[4][2];
#pragma unroll
    for (int mt = 0; mt < 4; ++mt) { acc[mt][0] = (f32x4){0.f, 0.f, 0.f, 0.f}; acc[mt][1] = (f32x4){0.f, 0.f, 0.f, 0.f}; }
#pragma unroll
    for (int kk = 0; kk < 4; ++kk) {
        bf16x8 bf[2];
#pragma unroll
        for (int nt = 0; nt < 2; ++nt) bf[nt] = __builtin_nontemporal_load((const bf16x8*)(st + (size_t)(32 * wave + 16 * nt + l15) * 128 + kk * 32 + quad * 8));
#pragma unroll
        for (int mt = 0; mt < 4; ++mt) { const bf16x8 af = *(const bf16x8*)(q + (size_t)(16 * mt + l15) * 512 + kk * 32 + quad * 8);
            acc[mt][0] = __builtin_amdgcn_mfma_f32_16x16x32_bf16(af, bf[0], acc[mt][0], 0, 0, 0);
            acc[mt][1] = __builtin_amdgcn_mfma_f32_16x16x32_bf16(af, bf[1], acc[mt][1], 0, 0, 0); }
    }
    float* ssq = (float*)lds;
    const float sc = 0.08838834764831845f;
#pragma unroll
    for (int mt = 0; mt < 4; ++mt)
#pragma unroll
        for (int j = 0; j < 4; ++j) { acc[mt][0][j] *= sc; acc[mt][1][j] *= sc;
            float s = acc[mt][0][j] * acc[mt][0][j] + acc[mt][1][j] * acc[mt][1][j];
            s += __shfl_xor(s, 1); s += __shfl_xor(s, 2); s += __shfl_xor(s, 4); s += __shfl_xor(s, 8);
            if (l15 == 0) ssq[wave * 64 + 16 * mt + 4 * quad + j] = s; }
    __syncthreads();
    const float* hn = a.in[11];
    const float g0 = hn[32 * wave + l15], g1 = hn[32 * wave + 16 + l15];
    const bf16* sgr = (const bf16*)(ws + WS_SGR) + t0 * 1024 + h * 256 + 32 * wave + l15;
    bf16* yg = (bf16*)(ws + WS_YF) + t0 * 2048 + 1024 + h * 256 + 32 * wave + l15;
#pragma unroll
    for (int mt = 0; mt < 4; ++mt)
#pragma unroll
        for (int j = 0; j < 4; ++j) { const int f = 16 * mt + 4 * quad + j; float tot = 0.f;
#pragma unroll
            for (int w = 0; w < 8; ++w) tot += ssq[w * 64 + f];
            const float rstd = __builtin_amdgcn_rsqf(tot * (1.0f / GVD) + EPS);
            yg[(size_t)f * 2048] = (bf16)f2bf(acc[mt][0][j] * rstd * g0 * bf2f(sgr[(size_t)f * 1024]));
            yg[(size_t)f * 2048 + 16] = (bf16)f2bf(acc[mt][1][j] * rstd * g1 * bf2f(sgr[(size_t)f * 1024 + 16])); }
    __syncthreads();
}

#define RLX_AGENT __ATOMIC_RELAXED, __HIP_MEMORY_SCOPE_AGENT
#define XB_TMO      128
#define XB_XCNT(j)  (256  + 64 * (j))
#define XB_XSUB(j)  (1280 + 64 * (j))
#define XB_XGEN(j)  (2304 + 64 * (j))
#define XB_TOP      3328
#define XB_TOPGEN   3392
#define XCD_BAR_WORDS 3456
#define XB_SPIN_CAP (1u << 18)

__device__ __forceinline__ unsigned xb_ld(unsigned* p)              { return __hip_atomic_load(p, __ATOMIC_RELAXED, __HIP_MEMORY_SCOPE_AGENT); }
__device__ __forceinline__ unsigned xb_add(unsigned* p, unsigned v) { return __hip_atomic_fetch_add(p, v, __ATOMIC_RELAXED, __HIP_MEMORY_SCOPE_AGENT); }
__device__ __forceinline__ unsigned xb_xcc_id() { return (unsigned)__builtin_amdgcn_s_getreg((3 << 11) | 20) & 0xFu; }
#define XB_SPIN(cond, bar) do { unsigned _sp = 0; while (cond) { __builtin_amdgcn_s_sleep(1); \
    if ((++_sp & 255u) == 0u) { if (xb_ld(&(bar)[XB_TMO])) break; if (_sp > XB_SPIN_CAP) { atomicAdd(&(bar)[XB_TMO], 1u); break; } } } } while (0)

struct XcdBarrier {
    unsigned* bar; unsigned x;
    volatile LAS unsigned* st;
};

__device__ __forceinline__ XcdBarrier xcd_barrier_post(unsigned* bar, volatile LAS unsigned* st) {
    XcdBarrier b; b.bar = bar; b.x = xb_xcc_id(); b.st = st;
    if (threadIdx.x == 0) (void)xb_add(&bar[XB_XCNT(b.x)], 1u);
    return b;
}
__device__ __forceinline__ void xcd_barrier_complete(unsigned* bar, unsigned x, unsigned& nloc, unsigned& nx) {
    const unsigned G = gridDim.x * gridDim.y * gridDim.z;
    unsigned sum, cnt, mine, sp = 0u;
    for (;;) {
        sum = 0u; cnt = 0u; mine = 0u;
#pragma unroll
        for (unsigned j = 0; j < 16; ++j) { const unsigned c = xb_ld(&bar[XB_XCNT(j)]); sum += c; cnt += (c > 0u) ? 1u : 0u; mine = (j == x) ? c : mine; }
        if (sum == G) break;
        __builtin_amdgcn_s_sleep(1);
        if ((++sp & 255u) == 0u) { if (xb_ld(&bar[XB_TMO])) break; if (sp > XB_SPIN_CAP) { atomicAdd(&bar[XB_TMO], 1u); break; } }
    }
    nloc = mine > 0u ? mine : 1u; nx = cnt > 0u ? cnt : 1u;
}

__device__ __forceinline__ void xcd_barrier(const XcdBarrier& b) {
    asm volatile("s_waitcnt vmcnt(0)" ::: "memory");
    __syncthreads();
    if (threadIdx.x == 0) {
        unsigned* bar = b.bar;
        __builtin_amdgcn_s_waitcnt(0);
        unsigned nloc = b.st[0], nx = b.st[1];
        if (nloc == 0u) { xcd_barrier_complete(bar, b.x, nloc, nx); b.st[0] = nloc; b.st[1] = nx; }
        const unsigned old = xb_add(&bar[XB_XSUB(b.x)], 1u);
        const unsigned gen = old / nloc;
        if (old + 1u == (gen + 1u) * nloc) {
            __builtin_amdgcn_fence(__ATOMIC_RELEASE, "agent");
            asm volatile("s_waitcnt vmcnt(0)" ::: "memory");
            const unsigned og = xb_add(&bar[XB_TOP], 1u);
            const unsigned tg = og / nx;
            if (og + 1u == (tg + 1u) * nx) xb_add(&bar[XB_TOPGEN], 1u);
            else XB_SPIN(xb_ld(&bar[XB_TOPGEN]) == tg, bar);
            __builtin_amdgcn_fence(__ATOMIC_ACQUIRE, "agent");
            xb_add(&bar[XB_XGEN(b.x)], 1u);
            asm volatile("s_waitcnt vmcnt(0)" ::: "memory");
        } else {
            XB_SPIN(xb_ld(&bar[XB_XGEN(b.x)]) == gen, bar);
            __builtin_amdgcn_fence(__ATOMIC_ACQUIRE, "agent");
            asm volatile("s_waitcnt vmcnt(0)" ::: "memory");
        }
    }
    __syncthreads();
}

__device__ __forceinline__ void sub_barrier(unsigned* ctr, unsigned target) {
    asm volatile("s_waitcnt vmcnt(0)" ::: "memory");
    __syncthreads();
    if (threadIdx.x == 0) {
        __builtin_amdgcn_fence(__ATOMIC_RELEASE, "agent");
        asm volatile("s_waitcnt vmcnt(0)" ::: "memory");
        (void)__hip_atomic_fetch_add(ctr, 1u, __ATOMIC_RELAXED, __HIP_MEMORY_SCOPE_AGENT);
        unsigned sp = 0;
        while (__hip_atomic_load(ctr, __ATOMIC_RELAXED, __HIP_MEMORY_SCOPE_AGENT) < target) { __builtin_amdgcn_s_sleep(2); if (++sp > (1u << 22)) break; }
        __builtin_amdgcn_fence(__ATOMIC_ACQUIRE, "agent");
        asm volatile("s_waitcnt vmcnt(0)" ::: "memory");
    }
    __syncthreads();
}

__global__ void __launch_bounds__(512, 2) fwd_kernel(Args a_unused) {
    extern __shared__ __attribute__((aligned(16))) unsigned char lds[];
    cg::grid_group grid = cg::this_grid();
    LAS unsigned char* ldsg = (LAS unsigned char*)lds;
    volatile LAS unsigned* bst = (volatile LAS unsigned*)(ldsg + LDS_AUX + 4096);
    if (threadIdx.x < 2) bst[threadIdx.x] = 0u;
    __syncthreads();
    const XcdBarrier xbar = xcd_barrier_post((unsigned*)((const Args*)__builtin_amdgcn_kernarg_segment_ptr())->ws + WS_BAR / 4, bst);
    typedef const __attribute__((address_space(4))) Args* kargp;
    kargp kap = (kargp)__builtin_amdgcn_kernarg_segment_ptr();
#define FRESH() asm volatile("" : "+s"(kap)); const Args a = *(const Args*)kap; unsigned char* ws = a.ws; float* H = a.out; (void)ws; (void)H; \
    const int tid = opaque_tid(), lane = tid & 63, wave = __builtin_amdgcn_readfirstlane(tid >> 6), G = gridDim.x, bx = blockIdx.x, gw = bx * 8 + wave, NGW = G * 8; (void)lane; (void)gw; (void)NGW;

    {   FRESH()
    p0_prologue(a, lds, gw, NGW, wave, lane);
    }
    if (gridDim.y == 0x7fffu) grid.sync();
    xcd_barrier(xbar);
    {   FRESH()
    { const int Gg = (G > 4 * NCONV) ? G - NCONV : G;
      if (bx < Gg) {
      pg8::Gemm g{(const bf16*)(ws + WS_XN), (const bf16*)(ws + WS_WGU1), T, 2 * DFF, DM}; pg8::StaticOrder S; S.init(T, 2 * DFF, Gg, bx);
      pg8::Epi<pg8::EPI_SWIGLU> E{}; E.dstb = (bf16*)(ws + WS_ACT); E.rs = (const float*)(ws + WS_SSQ) + 4 * T;
      pg8::gemm_phase<pg8::Epi<pg8::EPI_SWIGLU>, pg8::StaticOrder, true, true>(ldsg, g, S, E); }
      if (Gg == G) convert_set<1>(a, lds, gw, NGW, wave, lane);
      else if (bx >= Gg) convert_set<1>(a, lds, (bx - Gg) * 8 + wave, (G - Gg) * 8, wave, lane); }
    }
    xcd_barrier(xbar);
    {   FRESH()
    { pg8::Gemm g{(const bf16*)(ws + WS_ACT), (const bf16*)(ws + WS_WD1), T, DM, DFF}; pg8::StaticOrder S; S.init(T, DM, G, bx);
      pg8::Epi<pg8::EPI_RES> E{}; E.srcb = (const bf16*)(ws + WS_XN); E.dstf = nullptr; E.alpha = 0.5f; E.dstb = (bf16*)H; E.ssq = (float*)(ws + WS_SSQ);
      pg8::gemm_phase<pg8::Epi<pg8::EPI_RES>, pg8::StaticOrder, true, true>(ldsg, g, S, E); }
    }
    xcd_barrier(xbar);
    {   FRESH()
    p3_rows(a, H, lds, bx, G, tid);
    { pg8::Gemm g{(const bf16*)H, (const bf16*)(ws + WS_W4), T, N4, DM}; pg8::StaticOrder S; S.init(T, N4, G, bx);
      pg8::Epi<pg8::EPI_P4> E{}; E.ws = ws; E.bias = a.in[15]; E.rs = (const float*)(ws + WS_SSQ);
      pg8::gemm_phase<pg8::Epi<pg8::EPI_P4>, pg8::StaticOrder, true, true>(ldsg, g, S, E); }
    }
    xcd_barrier(xbar);
    {   FRESH()
    { const int nA = (G >= 2) ? G / 2 : 1;
      if (bx < nA) { const int item0 = (nA % 8 == 0) ? (bx & 7) * (nA / 8) + (bx >> 3) : bx;
          fox::attn_phase((char*)lds, ws, item0, nA); }
      if (G < 2 || bx >= nA) { const int first = (G < 2) ? 0 : bx - nA, stride = (G < 2) ? 1 : G - nA;
          unsigned* ctr = (unsigned*)(ws + WS_BAR) + 4096;
          for (int u = first; u < 512; u += stride) gla_g1(ws, lds, u, tid);
          sub_barrier(ctr, (unsigned)stride);
          gla_g2(ws, first * 512 + tid, stride * 512);
          sub_barrier(ctr, 2u * (unsigned)stride);
          for (int u = first; u < 512; u += stride) gla_g3(a, lds, u, tid);
          convert_set<3>(a, lds, first * 8 + wave, stride * 8, wave, lane); } }
    }
    xcd_barrier(xbar);
    {   FRESH()
    { pg8::Gemm g{(const bf16*)(ws + WS_YF), (const bf16*)(ws + WS_WA), T, DM, 2048}; pg8::StaticOrder S; S.init(T, DM, G, bx);
      pg8::Epi<pg8::EPI_MERGE2> E{}; E.dstb = (bf16*)(ws + WS_XN); E.gates = (const bf16*)(ws + WS_GATES);
      pg8::gemm_phase<pg8::Epi<pg8::EPI_MERGE2>, pg8::StaticOrder, true, true>(ldsg, g, S, E); }
    }
    xcd_barrier(xbar);
    {   FRESH()
    { pg8::Gemm g{(const bf16*)(ws + WS_XN), (const bf16*)(ws + WS_WOUT), T, DM, DM}; pg8::StaticOrder S; S.init(T, DM, G, bx);
      pg8::Epi<pg8::EPI_RES> E{}; E.srcb = (const bf16*)H; E.dstf = nullptr; E.alpha = 1.0f; E.dstb = (bf16*)(ws + WS_XN2); E.ssq = (float*)(ws + WS_SSQ) + T;
      pg8::gemm_phase<pg8::Epi<pg8::EPI_RES>, pg8::StaticOrder, true, true>(ldsg, g, S, E); }
    }
    xcd_barrier(xbar);
    {   FRESH()
    { const int Gg = (G > 4 * NCONV) ? G - NCONV : G;
      if (bx < Gg) {
      pg8::Gemm g{(const bf16*)(ws + WS_XN2), (const bf16*)(ws + WS_WGU2), T, 2 * DFF, DM}; pg8::StaticOrder S; S.init(T, 2 * DFF, Gg, bx);
      pg8::Epi<pg8::EPI_SWIGLU> E{}; E.dstb = (bf16*)(ws + WS_ACT); E.rs = (const float*)(ws + WS_SSQ) + T;
      pg8::gemm_phase<pg8::Epi<pg8::EPI_SWIGLU>, pg8::StaticOrder, true, true>(ldsg, g, S, E); }
      if (Gg == G) convert_set<2>(a, lds, gw, NGW, wave, lane);
      else if (bx >= Gg) convert_set<2>(a, lds, (bx - Gg) * 8 + wave, (G - Gg) * 8, wave, lane);
      if (Gg == G || bx >= Gg) { const int Gc = (Gg == G) ? G : G - Gg, cx = (Gg == G) ? bx : bx - Gg;
          __syncthreads();
          pg8::Gemm g{(const bf16*)(ws + WS_PB), (const bf16*)(ws + WS_WPE), T, DM, PLE}; pg8::StaticOrder S; S.init(T, DM, Gc, cx);
          pg8::Epi<pg8::EPI_PE> E{}; E.dstb = (bf16*)(ws + WS_PE);
          pg8::gemm_phase<pg8::Epi<pg8::EPI_PE>, pg8::StaticOrder, true, true>(ldsg, g, S, E); } }
    }
    xcd_barrier(xbar);
    {   FRESH()
    { pg8::Gemm g{(const bf16*)(ws + WS_ACT), (const bf16*)(ws + WS_WD2), T, DM, DFF}; pg8::StaticOrder S; S.init(T, DM, G, bx);
      pg8::Epi<pg8::EPI_RES> E{}; E.srcb = (const bf16*)(ws + WS_XN2); E.dstf = nullptr; E.alpha = 0.5f; E.dstb = (bf16*)(ws + WS_XN); E.ssq = (float*)(ws + WS_SSQ) + 2 * T;
      pg8::gemm_phase<pg8::Epi<pg8::EPI_RES>, pg8::StaticOrder, true, true>(ldsg, g, S, E); }
    }
    xcd_barrier(xbar);
    {   FRESH()
    { pg8::Gemm g{(const bf16*)(ws + WS_XN), (const bf16*)(ws + WS_WPG), T, DM, DM}; pg8::StaticOrder S; S.init(T, DM, G, bx);
      if ((T / 256) * (DM / 256) <= G) {
      pg8::Epi<pg8::EPI_FINAL> E{}; E.pe = (const bf16*)(ws + WS_PE); E.srcb = (const bf16*)(ws + WS_XN); E.dstf = H; E.rs = (const float*)(ws + WS_SSQ) + 2 * T; E.ssq = (float*)(ws + WS_SSQ) + 3 * T;
      E.cnt = (unsigned*)(ws + WS_BAR) + 6144; E.gain = a.in[24];
      pg8::gemm_phase<pg8::Epi<pg8::EPI_FINAL>, pg8::StaticOrder, true, true>(ldsg, g, S, E);
      } else {
      pg8::Epi<pg8::EPI_PLE> E{}; E.pe = (const bf16*)(ws + WS_PE); E.srcb = (const bf16*)(ws + WS_XN); E.dstf = H; E.rs = (const float*)(ws + WS_SSQ) + 2 * T;
      pg8::gemm_phase<pg8::Epi<pg8::EPI_PLE>, pg8::StaticOrder, true, true>(ldsg, g, S, E);
      xcd_barrier(xbar);
      for (int m = gw; m < T; m += NGW) rms_row<true>(H + (size_t)m * DM, a.in[24], H + (size_t)m * DM, lane); } }

    }
}

extern "C" void kernel_launch(void* const* d_in, const int* in_sizes, int n_in, void* d_out, int out_size, void* d_ws, size_t ws_size, hipStream_t stream) {
    static int grid = 0;
    if (grid == 0) {
        if (n_in != 25 || out_size != T * DM || ws_size < WS_END) { fprintf(stderr, "kernel_launch: unexpected shapes (n_in %d out %d ws %zu need %zu)\n", n_in, out_size, ws_size, (size_t)WS_END); grid = -1; return; }
        int dev = 0, cus = 0, per_cu = 0;
        (void)hipGetDevice(&dev);
        (void)hipDeviceGetAttribute(&cus, hipDeviceAttributeMultiprocessorCount, dev);
        (void)hipFuncSetAttribute((const void*)fwd_kernel, hipFuncAttributeMaxDynamicSharedMemorySize, LDS_BYTES);
        (void)hipOccupancyMaxActiveBlocksPerMultiprocessor(&per_cu, (const void*)fwd_kernel, 512, LDS_BYTES);
        if (per_cu < 1) { fprintf(stderr, "kernel_launch: occupancy query says %d\n", per_cu); }
        (void)hipGetLastError();
        grid = cus > 0 ? cus : 256;
    }
    if (grid < 0) return;
    (void)hipMemsetAsync((unsigned char*)d_ws + WS_BAR, 0, 32768, stream);
    Args a{};
    for (int i = 0; i < 25; ++i) a.in[i] = (const float*)d_in[i];
    a.out = (float*)d_out; a.ws = (unsigned char*)d_ws;
    void* args[] = {&a};
    hipError_t e = hipLaunchCooperativeKernel((const void*)fwd_kernel, dim3(grid), dim3(512), args, LDS_BYTES, stream);
    if (e != hipSuccess) fprintf(stderr, "cooperative launch failed: %s (grid %d)\n", hipGetErrorString(e), grid);
}
```

```cpp
#include <hip/hip_runtime.h>
#include <hip/hip_cooperative_groups.h>
#include <hip/hip_bf16.h>
#include <cstdio>
#include <cstdint>
#include <cmath>
namespace cg = cooperative_groups;

constexpr int NB = 2, SEQ = 4096, T = NB * SEQ, DM = 2048, DFF = 5632, DIN = 6168;
constexpr int FOXH = 8, HD = 128, GLAH = 4, GKD = 128, GVD = 256, RANK = 16, PLE = 256, CHUNK = 64, NCH = SEQ / CHUNK;
constexpr float EPS = 1e-6f;
constexpr int N4 = 10240;

constexpr size_t MiB = 1u << 20;
constexpr size_t SZ_WGU = (size_t)2 * DFF * DM * 2, SZ_WD = (size_t)DM * DFF * 2;
constexpr size_t WS_WGU1 = 0;
constexpr size_t WS_WD1 = WS_WGU1 + SZ_WGU;
constexpr size_t WS_GATES = 0;
constexpr size_t WS_W4 = WS_WD1 + SZ_WD;
constexpr size_t WS_WA = WS_W4 + (size_t)N4 * DM * 2;
constexpr size_t WS_WB = WS_WA + (size_t)DM * 1024 * 2;
constexpr size_t WS_WOUT = WS_WB + (size_t)DM * 1024 * 2;
constexpr size_t WS_WGU2 = WS_WOUT + (size_t)DM * DM * 2;
constexpr size_t WS_WD2 = WS_WGU2 + SZ_WGU;
constexpr size_t WS_WPG = WS_WD2 + SZ_WD;
constexpr size_t WS_WPE = WS_WPG + (size_t)DM * DM * 2;
constexpr size_t WS_WSM = WS_WPE + (size_t)DM * PLE * 2;
constexpr size_t WS_XN = ((WS_WSM + (size_t)24 * DM * 4 + 4095) / 4096) * 4096;
constexpr size_t WS_ACT = WS_XN + (size_t)T * DM * 2;
constexpr size_t WS_FQ = WS_ACT, WS_FK = WS_FQ + (size_t)T * 1024 * 2, WS_FV = WS_FK + (size_t)T * 1024 * 2;
constexpr size_t WS_GQ = WS_FV + (size_t)T * 1024 * 2, WS_GK = WS_GQ + (size_t)T * 512 * 2, WS_GV = WS_GK + (size_t)T * 512 * 2;
constexpr size_t WS_Z1 = WS_ACT;
constexpr size_t WS_PE = 0;
constexpr size_t WS_SGR = WS_ACT + (size_t)T * DFF * 2;
constexpr size_t WS_YF = WS_SGR + (size_t)T * 1024 * 2;
constexpr size_t WS_YG = WS_YF + (size_t)T * 1024 * 2;
constexpr size_t WS_KV = WS_YG + (size_t)T * 1024 * 2;
constexpr size_t WS_PB = WS_KV + (size_t)64 * MiB;
constexpr size_t WS_LA = WS_PB + (size_t)T * PLE * 2;
constexpr size_t WS_LF = WS_LA + (size_t)T * 512 * 4;
constexpr size_t WS_FS = WS_LF + (size_t)T * 8 * 4;
constexpr size_t WS_DEC = WS_FS + (size_t)16 * SEQ * 4;
constexpr size_t WS_BAR = WS_DEC + (size_t)8 * 64 * 128 * 4;
constexpr size_t WS_SSQ = WS_BAR + 32768;
constexpr size_t WS_XN2 = WS_KV;
constexpr size_t WS_END = WS_SSQ + (size_t)5 * T * 4;
static_assert(WS_WGU1 + SZ_WGU + SZ_WD >= WS_GATES + (size_t)T * 4096 * 2, "gates overlay");
static_assert(WS_GV + (size_t)T * 1024 * 2 <= WS_SGR, "mixer temporaries inside ACT");

constexpr int LDS_BYTES = 147456;
constexpr int LDS_AUX = 131072;

struct Args { const float* in[25]; float* out; unsigned char* ws; };

__device__ __forceinline__ float dpp_f(float v, const int ctrl_sel) {
    const int x = __builtin_bit_cast(int, v); int r;
    if (ctrl_sel == 0) r = __builtin_amdgcn_update_dpp(0, x, 0xB1, 0xf, 0xf, false);
    else if (ctrl_sel == 1) r = __builtin_amdgcn_update_dpp(0, x, 0x4E, 0xf, 0xf, false);
    else if (ctrl_sel == 2) r = __builtin_amdgcn_update_dpp(0, x, 0x141, 0xf, 0xf, false);
    else r = __builtin_amdgcn_update_dpp(0, x, 0x140, 0xf, 0xf, false);
    return __builtin_bit_cast(float, r);
}
__device__ __forceinline__ float wave_sum(float v) {
    v += dpp_f(v, 0); v += dpp_f(v, 1); v += dpp_f(v, 2); v += dpp_f(v, 3);
    v += __shfl_xor(v, 16);
    { auto rr = __builtin_amdgcn_permlane32_swap(__float_as_uint(v), __float_as_uint(v), false, false); v = __uint_as_float(rr[0]) + __uint_as_float(rr[1]); }
    return v;
}
__device__ __forceinline__ unsigned f2bf(float f) { unsigned u = __builtin_bit_cast(unsigned, f); return (u + 0x7fffu + ((u >> 16) & 1u)) >> 16; }
__device__ __forceinline__ unsigned pk2(float lo, float hi) { return f2bf(lo) | (f2bf(hi) << 16); }
__device__ __forceinline__ float bf2f(unsigned short b) { return __builtin_bit_cast(float, (unsigned)b << 16); }
__device__ __forceinline__ float sigmoid_f(float x) { return __builtin_amdgcn_rcpf(1.0f + __builtin_amdgcn_exp2f(-1.4426950408889634f * x)); }
__device__ __forceinline__ float silu_f(float x) { return x * sigmoid_f(x); }
__device__ __forceinline__ float logsigmoid_f(float x) { return fminf(x, 0.f) - __logf(1.0f + __expf(-fabsf(x))); }

__device__ __forceinline__ int opaque_tid() { int t = (int)threadIdx.x; asm volatile("" : "+v"(t)); return t; }

namespace pg8 {
#define PG8_LAS __attribute__((address_space(3)))
typedef unsigned short bf16_t;
typedef short bf16x8 __attribute__((ext_vector_type(8)));
typedef float f32x4 __attribute__((ext_vector_type(4)));
typedef unsigned u32x4 __attribute__((ext_vector_type(4)));
constexpr int BM = 256, BK = 64, HALF = 128, HTB = HALF * BK * 2  , STAGE_BYTES = 8 * HTB, NXCD = 8, WGM = 8;

__host__ __device__ __forceinline__ int lds_byte(int r, int c) { const int st = (r >> 4) * 2 + (c >> 5), rr = r & 15, cc = c & 31, ob = rr * 64 + cc * 2; return st * 1024 + (ob ^ (((ob >> 9) & 1) << 5)); }
__host__ __device__ __forceinline__ void stage_rc(int b, int& R, int& C) { const int st = b / 1024, sb = b % 1024, swz = sb ^ (((sb >> 9) & 1) << 5); R = (st >> 1) * 16 + swz / 64; C = (st & 1) * 32 + (swz % 64) / 2; }
__host__ __device__ __forceinline__ int perm32(int rho) { const int n = rho >> 4, i = rho & 15; return 8 * (i >> 2) + 4 * n + (i & 3); }

struct Unit { int pm, pn; };
struct Gemm { const bf16_t* A; const bf16_t* Bt; int M, N, K; };

struct StaticOrder {
    int nM, nN, nwg, G, c;
    __host__ __device__ void init(int M, int N, int G_, int c_) { nM = M / BM; nN = N / BM; nwg = nM * nN; G = G_; c = c_; }
    __host__ __device__ bool next(int i, Unit& u) const {
        const long L = (long)i * G + c; if (L >= nwg) return false;
        int wgid = (int)L; { const int q = nwg / NXCD, r = nwg % NXCD, xcd = wgid % NXCD, off = wgid / NXCD; wgid = (xcd < r ? xcd * (q + 1) : r * (q + 1) + (xcd - r) * q) + off; }
        const int nig = WGM * nN, gid = wgid / nig, fm = gid * WGM, gsz = (nM - fm) < WGM ? (nM - fm) : WGM;
        u.pm = fm + ((wgid % nig) % gsz); u.pn = (wgid % nig) / gsz; return true;
    }
    __device__ __forceinline__ void a_ready(const Unit&) const {}
    __device__ __forceinline__ void done(const Unit&) const {}
};

template <class Epi, class Sched, bool ALIGN_EPI = false, bool SP2 = false>
__device__ __forceinline__ void gemm_phase(PG8_LAS unsigned char* lds, const Gemm g, const Sched& S, const Epi& E) {
    const int tid = opaque_tid(), wid = __builtin_amdgcn_readfirstlane(tid >> 6), lane = tid & 63, wr = wid >> 2, wc = wid & 3, fr = lane & 15, fq = lane >> 4;
    const int K = g.K, nt = K / BK;
    unsigned voffA[2], voffB[2];
#pragma unroll
    for (int i = 0; i < 2; ++i) { int R, C; stage_rc(tid * 16 + i * 8192, R, C); const int Rb = Epi::PERM ? ((R & ~31) + perm32(R & 31)) : R;
        voffA[i] = (unsigned)(R * K + C) * 2u; voffB[i] = (unsigned)(Rb * K + C) * 2u; }
    const size_t kstep = (size_t)(BK * 2);
    const size_t hstep = (size_t)HALF * K * 2;
    const size_t tstep = 2 * hstep;
    const unsigned ldsw = (unsigned)wid * 1024u;
    const int aoff = lds_byte(wr * 64 + fr, fq * 8), boff = lds_byte(wc * 32 + fr, fq * 8);
#define PG8_SA(b, h) (((b) * 2 + (h)) * HTB)
#define PG8_SB(b, h) ((4 + (b) * 2 + (h)) * HTB)
#define PG8_STAGE(bufoff, gbase, voff) do { _Pragma("unroll") for (int _i = 0; _i < 2; ++_i) \
        __builtin_amdgcn_global_load_lds((const unsigned*)((const char*)(gbase) + (voff)[_i]), (PG8_LAS unsigned*)(lds + (bufoff) + ldsw + _i * 8192), 16, 0, 0); } while (0)
#define PG8_LDA(dst, b, h) do { _Pragma("unroll") for (int m = 0; m < 4; ++m) _Pragma("unroll") for (int k = 0; k < 2; ++k) dst[m][k] = *(const PG8_LAS bf16x8*)(lds + PG8_SA(b, h) + aoff + m * 2048 + k * 1024); } while (0)
#define PG8_LDB(dst, b, h) do { _Pragma("unroll") for (int n = 0; n < 2; ++n) _Pragma("unroll") for (int k = 0; k < 2; ++k) dst[n][k] = *(const PG8_LAS bf16x8*)(lds + PG8_SB(b, h) + boff + n * 2048 + k * 1024); } while (0)
#define PG8_MMA(ai, bj, At, Bt) do { __builtin_amdgcn_s_setprio(1); _Pragma("unroll") for (int m = 0; m < 4; ++m) _Pragma("unroll") for (int n = 0; n < 2; ++n) _Pragma("unroll") for (int k = 0; k < 2; ++k) \
        acc[ai][bj][m][n] = __builtin_amdgcn_mfma_f32_16x16x32_bf16(Bt[n][k], At[m][k], acc[ai][bj][m][n], 0, 0, 0); __builtin_amdgcn_s_setprio(0); } while (0)
#define PG8_WAIT_V(n) asm volatile("s_waitcnt vmcnt(" #n ")" ::: "memory")
#define PG8_WAIT_L(n) asm volatile("s_waitcnt lgkmcnt(" #n ")" ::: "memory")
#define PG8_BAR __builtin_amdgcn_s_barrier()
#define PG8_SCHED __builtin_amdgcn_sched_barrier(0)
    Unit cur, nxt; int ui = 0;
    if (!S.next(0, cur)) return;
    f32x4 acc[2][2][4][2];
#pragma unroll
    for (int a = 0; a < 2; ++a)
#pragma unroll
        for (int b = 0; b < 2; ++b)
#pragma unroll
            for (int m = 0; m < 4; ++m)
#pragma unroll
                for (int n = 0; n < 2; ++n) acc[a][b][m][n] = (f32x4){0.f, 0.f, 0.f, 0.f};
    bf16x8 At[4][2], B0[2][2], B1[2][2];
    const char* cA = (const char*)g.A + (size_t)cur.pm * tstep; const char* cB = (const char*)g.Bt + (size_t)cur.pn * tstep;
    S.a_ready(cur);
    if constexpr (SP2) {
        PG8_STAGE(PG8_SB(0, 0), cB, voffB); PG8_STAGE(PG8_SB(0, 1), cB + hstep, voffB); PG8_STAGE(PG8_SA(0, 0), cA, voffA); PG8_STAGE(PG8_SA(0, 1), cA + hstep, voffA);
        if (wr == 1) PG8_BAR;
        PG8_WAIT_V(2); PG8_BAR;
        PG8_STAGE(PG8_SB(1, 0), cB + kstep, voffB); PG8_STAGE(PG8_SA(1, 0), cA + kstep, voffA); PG8_STAGE(PG8_SB(1, 1), cB + hstep + kstep, voffB);
        PG8_WAIT_V(6); PG8_BAR;
    } else {
        PG8_STAGE(PG8_SB(0, 0), cB, voffB); PG8_STAGE(PG8_SA(0, 0), cA, voffA); PG8_STAGE(PG8_SB(0, 1), cB + hstep, voffB); PG8_STAGE(PG8_SA(0, 1), cA + hstep, voffA);
        if (wr == 1) PG8_BAR;
        PG8_WAIT_V(4); PG8_BAR;
        PG8_STAGE(PG8_SB(1, 0), cB + kstep, voffB); PG8_STAGE(PG8_SA(1, 0), cA + kstep, voffA); PG8_STAGE(PG8_SB(1, 1), cB + hstep + kstep, voffB);
        PG8_WAIT_V(6); PG8_BAR;
    }
    for (;;) {
        const bool has_next = S.next(ui + 1, nxt);
        const char* nA = has_next ? (const char*)g.A + (size_t)nxt.pm * tstep : cA; const char* nB = has_next ? (const char*)g.Bt + (size_t)nxt.pn * tstep : cB;
        for (int t = 0; t < nt; t += 2) {
            if constexpr (Epi::MIDK) { if (t == (nt >> 1)) E.mid(acc, cur, wr, wc, fr, fq); }
            const bool last = (t == nt - 2);
            const char* a1 = cA + (size_t)(t + 1) * kstep;
            const char* a2 = last ? nA : cA + (size_t)(t + 2) * kstep; const char* b2 = last ? nB : cB + (size_t)(t + 2) * kstep;
            const char* a3 = a2 + kstep; const char* b3 = b2 + kstep;
            if (last && has_next) S.a_ready(nxt);
            if constexpr (SP2) {
            PG8_LDB(B0, 0, 0); PG8_LDB(B1, 0, 1); PG8_SCHED; PG8_LDA(At, 0, 0); PG8_STAGE(PG8_SA(1, 1), a1 + hstep, voffA);
            PG8_WAIT_V(8); PG8_WAIT_L(0); PG8_BAR; PG8_MMA(0, 0, At, B0); PG8_MMA(0, 1, At, B1); PG8_BAR; PG8_SCHED;
            PG8_LDA(At, 0, 1); PG8_STAGE(PG8_SB(0, 0), b2, voffB); PG8_STAGE(PG8_SB(0, 1), b2 + hstep, voffB); PG8_STAGE(PG8_SA(0, 0), a2, voffA);
            PG8_WAIT_V(8); PG8_WAIT_L(0); PG8_BAR; PG8_MMA(1, 0, At, B0); PG8_MMA(1, 1, At, B1); PG8_BAR; PG8_SCHED;
            PG8_LDB(B0, 1, 0); PG8_LDB(B1, 1, 1); PG8_SCHED; PG8_LDA(At, 1, 0); PG8_STAGE(PG8_SA(0, 1), a2 + hstep, voffA);
            PG8_WAIT_V(8); PG8_WAIT_L(0); PG8_BAR; PG8_MMA(0, 0, At, B0); PG8_MMA(0, 1, At, B1); PG8_BAR; PG8_SCHED;
            PG8_LDA(At, 1, 1); PG8_STAGE(PG8_SB(1, 0), b3, voffB); PG8_STAGE(PG8_SB(1, 1), b3 + hstep, voffB); PG8_STAGE(PG8_SA(1, 0), a3, voffA);
            PG8_WAIT_V(8); PG8_WAIT_L(0); PG8_BAR; PG8_MMA(1, 0, At, B0); PG8_MMA(1, 1, At, B1); PG8_BAR; PG8_SCHED;
            } else {
            PG8_LDB(B0, 0, 0); PG8_SCHED; PG8_LDA(At, 0, 0); PG8_STAGE(PG8_SA(1, 1), a1 + hstep, voffA);
            PG8_WAIT_L(8); PG8_BAR; PG8_WAIT_L(0); PG8_MMA(0, 0, At, B0); PG8_BAR; PG8_SCHED;
            PG8_LDB(B1, 0, 1); PG8_STAGE(PG8_SB(0, 0), b2, voffB);
            PG8_BAR; PG8_WAIT_L(0); PG8_MMA(0, 1, At, B1); PG8_BAR;
            PG8_LDA(At, 0, 1); PG8_STAGE(PG8_SA(0, 0), a2, voffA);
            PG8_BAR; PG8_WAIT_L(0); PG8_MMA(1, 0, At, B0); PG8_BAR; PG8_SCHED;
            PG8_STAGE(PG8_SB(0, 1), b2 + hstep, voffB);
            PG8_WAIT_V(6); PG8_BAR; PG8_MMA(1, 1, At, B1); PG8_BAR;
            PG8_LDB(B0, 1, 0); PG8_SCHED; PG8_LDA(At, 1, 0); PG8_STAGE(PG8_SA(0, 1), a2 + hstep, voffA);
            PG8_WAIT_L(8); PG8_BAR; PG8_WAIT_L(0); PG8_MMA(0, 0, At, B0); PG8_BAR; PG8_SCHED;
            PG8_LDB(B1, 1, 1); PG8_STAGE(PG8_SB(1, 0), b3, voffB);
            PG8_BAR; PG8_WAIT_L(0); PG8_MMA(0, 1, At, B1); PG8_BAR;
            PG8_LDA(At, 1, 1); PG8_STAGE(PG8_SA(1, 0), a3, voffA);
            PG8_BAR; PG8_WAIT_L(0); PG8_MMA(1, 0, At, B0); PG8_BAR; PG8_SCHED;
            PG8_STAGE(PG8_SB(1, 1), b3 + hstep, voffB);
            PG8_WAIT_V(6); PG8_BAR; PG8_MMA(1, 1, At, B1); PG8_BAR;
            }
        }
        if constexpr (ALIGN_EPI) { if (wr == 0) PG8_BAR; }
        if constexpr (!Epi::AFTER_DRAIN) { E(acc, cur, wr, wc, fr, fq); S.done(cur); }
        if (!has_next) break;
#pragma unroll
        for (int a = 0; a < 2; ++a)
#pragma unroll
            for (int b = 0; b < 2; ++b)
#pragma unroll
                for (int m = 0; m < 4; ++m)
#pragma unroll
                    for (int n = 0; n < 2; ++n) acc[a][b][m][n] = (f32x4){0.f, 0.f, 0.f, 0.f};
        cur = nxt; cA = nA; cB = nB; ++ui;
        if constexpr (ALIGN_EPI) { if (wr == 1) PG8_BAR; }
    }
    PG8_WAIT_V(0);
    if constexpr (!ALIGN_EPI) { if (wr == 0) PG8_BAR; }
    PG8_BAR;
    if constexpr (Epi::AFTER_DRAIN) { E.fused(acc, cur, wr, wc, fr, fq, lds, wid, lane); S.done(cur); }
#undef PG8_SA
#undef PG8_SB
#undef PG8_STAGE
#undef PG8_LDA
#undef PG8_LDB
#undef PG8_MMA
#undef PG8_WAIT_V
#undef PG8_WAIT_L
#undef PG8_BAR
#undef PG8_SCHED
}
}
namespace pg8 {
__device__ __forceinline__ unsigned cvt_pk_bf16(float lo, float hi) { unsigned r; asm volatile("v_cvt_pk_bf16_f32 %0, %1, %2" : "=v"(r) : "v"(lo), "v"(hi)); return r; }
enum { EPI_SWIGLU = 0, EPI_RES = 1, EPI_P4 = 2, EPI_Z1 = 3, EPI_MERGE = 4, EPI_PLE = 5, EPI_PE = 6, EPI_FINAL = 7, EPI_MERGE2 = 8 };
__device__ __forceinline__ u32x4 pack8bf(f32x4 a, f32x4 b) { u32x4 w; w.x = cvt_pk_bf16(a[0], a[1]); w.y = cvt_pk_bf16(a[2], a[3]); w.z = cvt_pk_bf16(b[0], b[1]); w.w = cvt_pk_bf16(b[2], b[3]); return w; }
__device__ __forceinline__ void unpack8bf(u32x4 w, f32x4& a, f32x4& b) {
    a[0] = __builtin_bit_cast(float, w.x << 16); a[1] = __builtin_bit_cast(float, w.x & 0xffff0000u); a[2] = __builtin_bit_cast(float, w.y << 16); a[3] = __builtin_bit_cast(float, w.y & 0xffff0000u);
    b[0] = __builtin_bit_cast(float, w.z << 16); b[1] = __builtin_bit_cast(float, w.z & 0xffff0000u); b[2] = __builtin_bit_cast(float, w.w << 16); b[3] = __builtin_bit_cast(float, w.w & 0xffff0000u); }
__device__ __forceinline__ f32x4 sig4(f32x4 v) { f32x4 r; r[0] = sigmoid_f(v[0]); r[1] = sigmoid_f(v[1]); r[2] = sigmoid_f(v[2]); r[3] = sigmoid_f(v[3]); return r; }
__device__ __forceinline__ f32x4 silu4(f32x4 v) { return v * sig4(v); }
typedef unsigned u32x2 __attribute__((ext_vector_type(2)));
__device__ __forceinline__ unsigned q8(float g) { return (unsigned)fminf(fmaxf(g * 255.0f + 0.5f, 1.0f), 255.0f); }
__device__ __forceinline__ u32x2 pack8u8(f32x4 a, f32x4 b) { u32x2 w; w.x = q8(a[0]) | (q8(a[1]) << 8) | (q8(a[2]) << 16) | (q8(a[3]) << 24); w.y = q8(b[0]) | (q8(b[1]) << 8) | (q8(b[2]) << 16) | (q8(b[3]) << 24); return w; }
__device__ __forceinline__ void unpack8u8(u32x2 w, f32x4& a, f32x4& b) {
    a[0] = (float)(w.x & 0xffu); a[1] = (float)((w.x >> 8) & 0xffu); a[2] = (float)((w.x >> 16) & 0xffu); a[3] = (float)(w.x >> 24);
    b[0] = (float)(w.y & 0xffu); b[1] = (float)((w.y >> 8) & 0xffu); b[2] = (float)((w.y >> 16) & 0xffu); b[3] = (float)(w.y >> 24); }

template <int MODE> struct Epi {
    static constexpr bool PERM = true, AFTER_DRAIN = false, MIDK = (MODE == EPI_MERGE2);
    unsigned char* ws;
    const float* src;
    float* dstf;
    bf16_t* dstb;
    const bf16_t* gates;
    const float* bias;
    float alpha;
    float* ssq;
    unsigned* cnt;
    const float* gain;
    const bf16_t* srcb;
    const bf16_t* pe;
    const float* rs;
    __device__ __forceinline__ void mid(f32x4 (&acc)[2][2][4][2], const Unit& u, int wr, int wc, int fr, int fq) const {
        int rbase = u.pm * BM + wr * 64 + fr; asm volatile("" : "+v"(rbase));
        const unsigned cw = (unsigned)(u.pn * BM + wc * 32 + 8 * fq);
#pragma unroll
        for (int ai = 0; ai < 2; ++ai)
#pragma unroll
            for (int m = 0; m < 4; ++m) { const unsigned ro = (unsigned)(rbase + ai * HALF + m * 16) * 4096u + cw;
#pragma unroll
                for (int bj = 0; bj < 2; ++bj) {
                    const unsigned char* g8 = (const unsigned char*)gates;
                    f32x4 f0, f1, g0, g1; unpack8u8(__builtin_nontemporal_load((const u32x2*)(g8 + (ro + bj * HALF))), f0, f1); unpack8u8(*(const u32x2*)(g8 + (ro + 2048u + bj * HALF)), g0, g1);
#pragma unroll
                    for (int i = 0; i < 4; ++i) { acc[ai][bj][m][0][i] *= f0[i] * __builtin_amdgcn_rcpf(g0[i]); acc[ai][bj][m][1][i] *= f1[i] * __builtin_amdgcn_rcpf(g1[i]); } }
                asm volatile("" ::: "memory"); }
    }
    __device__ __forceinline__ void operator()(const f32x4 (&acc)[2][2][4][2], const Unit& u, int wr, int wc, int fr, int fq) const {
        const int row0 = u.pm * BM + wr * 64 + fr, cw = wc * 32 + 8 * fq;
        if constexpr (MODE == EPI_SWIGLU) {
#pragma unroll
            for (int ai = 0; ai < 2; ++ai)
#pragma unroll
                for (int m = 0; m < 4; ++m) { const size_t row = (size_t)(row0 + ai * HALF + m * 16);
                    const float rstd = rs ? __builtin_amdgcn_rsqf(rs[row] * (1.0f / DM) + EPS) : 1.0f;
                    const f32x4 a = silu4(acc[ai][0][m][0] * rstd) * (acc[ai][1][m][0] * rstd), b = silu4(acc[ai][0][m][1] * rstd) * (acc[ai][1][m][1] * rstd);
                    *(u32x4*)(dstb + row * DFF + u.pn * 128 + cw) = pack8bf(a, b); }
        } else if constexpr (MODE == EPI_P4) {
            const int pn = u.pn;
#pragma unroll
            for (int bj = 0; bj < 2; ++bj) {
                f32x4 bv0 = {0.f, 0.f, 0.f, 0.f}, bv1 = {0.f, 0.f, 0.f, 0.f};
                if (pn >= 24) { const float* bp = bias + (pn - 24) * 256 + bj * HALF + cw; bv0 = *(const f32x4*)bp; bv1 = *(const f32x4*)(bp + 4); }
#pragma unroll
                for (int ai = 0; ai < 2; ++ai)
#pragma unroll
                    for (int m = 0; m < 4; ++m) { const int row = row0 + ai * HALF + m * 16; const float rstd = __builtin_amdgcn_rsqf(rs[row] * (1.0f / DM) + EPS); f32x4 a = acc[ai][bj][m][0] * rstd, b = acc[ai][bj][m][1] * rstd; bf16_t* p;
                        if (pn < 12) { const int which = pn >> 2, head = (pn & 3) * 2 + bj, bb = row >> 12, s = row & 4095;
                            p = (bf16_t*)(ws + WS_FQ) + (size_t)which * T * 1024 + ((size_t)(bb * FOXH + head) * SEQ + s) * HD + cw; }
                        else if (pn < 14) p = (bf16_t*)(ws + WS_GQ) + (size_t)row * 512 + (pn - 12) * 256 + bj * HALF + cw;
                        else if (pn < 16) p = (bf16_t*)(ws + WS_GK) + (size_t)row * 512 + (pn - 14) * 256 + bj * HALF + cw;
                        else if (pn < 20) p = (bf16_t*)(ws + WS_GV) + (size_t)row * 1024 + (pn - 16) * 256 + bj * HALF + cw;
                        else if (pn < 24) { p = (bf16_t*)(ws + WS_SGR) + (size_t)row * 1024 + (pn - 20) * 256 + bj * HALF + cw; a = silu4(a); b = silu4(b); }
                        else { p = nullptr; a = sig4(a + bv0); b = sig4(b + bv1);
                            *(u32x2*)((unsigned char*)(ws + WS_GATES) + (size_t)row * 4096 + (pn - 24) * 256 + bj * HALF + cw) = pack8u8(a, b); }
                        if (p) *(u32x4*)p = pack8bf(a, b); }
            }
        } else if constexpr (MODE == EPI_FINAL) {
            f32x4 (&A)[2][2][4][2] = const_cast<f32x4 (&)[2][2][4][2]>(acc);
#pragma unroll
            for (int ai = 0; ai < 2; ++ai)
#pragma unroll
                for (int m = 0; m < 4; ++m) { const size_t row = (size_t)(row0 + ai * HALF + m * 16);
                    const float rstd = __builtin_amdgcn_rsqf(rs[row] * (1.0f / DM) + EPS); float sq = 0.f;
#pragma unroll
                    for (int bj = 0; bj < 2; ++bj) { const int col = u.pn * BM + bj * HALF + cw; const size_t off = row * DM + col;
                        f32x4 p0, p1, r0, r1; unpack8bf(__builtin_nontemporal_load((const u32x4*)(pe + off)), p0, p1); unpack8bf(*(const u32x4*)(srcb + off), r0, r1);
                        const f32x4 h0 = r0 + sig4(A[ai][bj][m][0] * rstd) * p0, h1 = r1 + sig4(A[ai][bj][m][1] * rstd) * p1;
                        A[ai][bj][m][0] = h0; A[ai][bj][m][1] = h1;
                        sq += (h0[0] * h0[0] + h0[1] * h0[1]) + (h0[2] * h0[2] + h0[3] * h0[3]) + (h1[0] * h1[0] + h1[1] * h1[1]) + (h1[2] * h1[2] + h1[3] * h1[3]); }
                    sq += __shfl_xor(sq, 16); sq += __shfl_xor(sq, 32);
                    if (fq == 0) (void)__hip_atomic_fetch_add(ssq + row, sq, __ATOMIC_RELAXED, __HIP_MEMORY_SCOPE_AGENT); }
            asm volatile("s_waitcnt vmcnt(0)" ::: "memory");
            unsigned* c = cnt + 64 * u.pm;
            if (fr == 0 && fq == 0) (void)__hip_atomic_fetch_add(c, 1u, __ATOMIC_RELAXED, __HIP_MEMORY_SCOPE_AGENT);
            { unsigned sp = 0; const unsigned want = 8u * (unsigned)(DM / BM);
              while ((unsigned)__builtin_amdgcn_readfirstlane(__hip_atomic_load(c, __ATOMIC_RELAXED, __HIP_MEMORY_SCOPE_AGENT)) < want) { __builtin_amdgcn_s_sleep(2); if (++sp > (1u << 22)) break; } }
            asm volatile("" ::: "memory");
#pragma unroll
            for (int ai = 0; ai < 2; ++ai)
#pragma unroll
                for (int m = 0; m < 4; ++m) { const size_t row = (size_t)(row0 + ai * HALF + m * 16);
                    const float tot = __hip_atomic_load(ssq + row, __ATOMIC_RELAXED, __HIP_MEMORY_SCOPE_AGENT);
                    const float rn = __builtin_amdgcn_rsqf(tot * (1.0f / DM) + EPS);
#pragma unroll
                    for (int bj = 0; bj < 2; ++bj) { const int col = u.pn * BM + bj * HALF + cw; const size_t off = row * DM + col;
                        const f32x4 g0 = *(const f32x4*)(gain + col), g1 = *(const f32x4*)(gain + col + 4);
                        __builtin_nontemporal_store(A[ai][bj][m][0] * rn * g0, (f32x4*)(dstf + off)); __builtin_nontemporal_store(A[ai][bj][m][1] * rn * g1, (f32x4*)(dstf + off + 4)); } }
        } else {
#pragma unroll
            for (int ai = 0; ai < 2; ++ai)
#pragma unroll
                for (int m = 0; m < 4; ++m) { const size_t row = (size_t)(row0 + ai * HALF + m * 16);
                    float sq = 0.f; float rstd = 1.0f;
                    if constexpr (MODE == EPI_PLE) rstd = __builtin_amdgcn_rsqf(rs[row] * (1.0f / DM) + EPS);
#pragma unroll
                    for (int bj = 0; bj < 2; ++bj) { const int col = u.pn * BM + bj * HALF + cw; const size_t off = row * DM + col;
                        f32x4 a = acc[ai][bj][m][0], b = acc[ai][bj][m][1];
                        if constexpr (MODE == EPI_RES) { f32x4 s0, s1;
                            if (srcb) unpack8bf(__builtin_nontemporal_load((const u32x4*)(srcb + off)), s0, s1); else { s0 = *(const f32x4*)(src + off); s1 = *(const f32x4*)(src + off + 4); }
                            const f32x4 h0 = s0 + alpha * a, h1 = s1 + alpha * b;
                            if (dstf) { *(f32x4*)(dstf + off) = h0; *(f32x4*)(dstf + off + 4) = h1; }
                            if (dstb) { *(u32x4*)(dstb + off) = pack8bf(h0, h1);
                                sq += (h0[0] * h0[0] + h0[1] * h0[1]) + (h0[2] * h0[2] + h0[3] * h0[3]) + (h1[0] * h1[0] + h1[1] * h1[1]) + (h1[2] * h1[2] + h1[3] * h1[3]); } }
                        else if constexpr (MODE == EPI_Z1) { f32x4 g0, g1; unpack8bf(*(const u32x4*)(gates + row * 4096 + col), g0, g1);
                            *(f32x4*)(dstf + off) = g0 * a; *(f32x4*)(dstf + off + 4) = g1 * b; }
                        else if constexpr (MODE == EPI_MERGE) { f32x4 g0, g1; unpack8bf(*(const u32x4*)(gates + row * 4096 + 2048 + col), g0, g1);
                            const f32x4 z0 = *(const f32x4*)(src + off), z1 = *(const f32x4*)(src + off + 4);
                            *(u32x4*)(dstb + off) = pack8bf(z0 + g0 * a, z1 + g1 * b); }
                        else if constexpr (MODE == EPI_MERGE2) { f32x4 g0, g1; unpack8u8(__builtin_nontemporal_load((const u32x2*)((const unsigned char*)gates + row * 4096 + 2048 + col)), g0, g1);
                            *(u32x4*)(dstb + off) = pack8bf(g0 * (a * (1.0f / 255.0f)), g1 * (b * (1.0f / 255.0f))); }
                        else if constexpr (MODE == EPI_PLE) { f32x4 p0, p1, h0, h1; unpack8bf(*(const u32x4*)(pe + off), p0, p1); unpack8bf(*(const u32x4*)(srcb + off), h0, h1);
                            *(f32x4*)(dstf + off) = h0 + sig4(a * rstd) * p0; *(f32x4*)(dstf + off + 4) = h1 + sig4(b * rstd) * p1; }
                        else { *(u32x4*)(dstb + off) = pack8bf(a, b); }
                    }
                    if constexpr (MODE == EPI_RES) { if (dstb) { sq += __shfl_xor(sq, 16); sq += __shfl_xor(sq, 32); if (fq == 0) (void)__hip_atomic_fetch_add(ssq + row, sq, __ATOMIC_RELAXED, __HIP_MEMORY_SCOPE_AGENT);   } }
                }
        }
    }
};
}

namespace fox {
constexpr int D = 128, NW = 8, QBLK = 32, KVBLK = 64, QB = NW * QBLK;
constexpr int SHM_V = KVBLK * D * 2, SHM_K = KVBLK * D * 2;
constexpr int LDS_WSF = 2 * SHM_V + 2 * SHM_K, LDS_F = LDS_WSF + NW * 64 * 4, LDS_END = LDS_F + SEQ * 4;
constexpr int OST = 2048;
constexpr float SCALE = 0.08838834764831845f;
constexpr float THR = 8.f;
using bf16 = __hip_bfloat16;
typedef short bf16x8 __attribute__((ext_vector_type(8)));
typedef short s16x4 __attribute__((ext_vector_type(4)));
typedef float f32x16 __attribute__((ext_vector_type(16)));
typedef float f32x4 __attribute__((ext_vector_type(4)));
typedef unsigned u32x4 __attribute__((ext_vector_type(4)));

#define KSWZ(row, colB) ((row) * 256 + ((colB) ^ (((row) & 7) << 4)))
#define SBAR() __builtin_amdgcn_sched_barrier(0)
__device__ __forceinline__ int v_st(int k, int c) { const int kk = (k & ~0xC) | ((k & 4) << 1) | ((k & 8) >> 1); return ((kk >> 3) * 4 + (c >> 5)) * 512 + ((kk & 7) * 32 + (c & 31)) * 2; }
__device__ __forceinline__ int v_rd_base(int lane) { return ((lane & 3) << 3) | (((lane >> 2) & 3) << 6) | (((lane >> 4) & 1) << 5) | (((lane >> 5) & 1) << 8); }
constexpr int v_rd_off(int d0, int ks, int half) { return d0 * 512 + ks * 4096 + half * 2048; }
__device__ __forceinline__ int crow(int r, int hi) { return (r & 3) + 8 * (r >> 2) + 4 * hi; }
__device__ __forceinline__ unsigned cvtpk(float lo, float hi) { unsigned r; asm volatile("v_cvt_pk_bf16_f32 %0, %1, %2" : "=v"(r) : "v"(lo), "v"(hi)); return r; }
__device__ __forceinline__ bf16x8 load8(const bf16* p) { return *reinterpret_cast<const bf16x8*>(p); }
__device__ __forceinline__ void mask_tile(f32x16& p0, f32x16& p1, int dq, unsigned W) {
    const float NEG = -__builtin_inff();
#pragma unroll
    for (int r = 0; r < 16; ++r) {
        const int c = (r & 3) + 8 * (r >> 2);
        if ((unsigned)(dq - c) >= W) p0[r] = NEG;
        if ((unsigned)(dq - c - 32) >= W) p1[r] = NEG;
    }
}
__device__ __forceinline__ void bias_tile(f32x16& p0, f32x16& p1, const float* fk) {
#pragma unroll
    for (int j = 0; j < 4; ++j) { const f32x4 a = *(const f32x4*)(fk + 8 * j), b = *(const f32x4*)(fk + 32 + 8 * j);
#pragma unroll
        for (int i = 0; i < 4; ++i) { p0[4 * j + i] -= a[i]; p1[4 * j + i] -= b[i]; }
        SBAR(); }
}
__device__ __forceinline__ void partialSM(f32x16& p0, f32x16& p1, float& m_reg, float& mn, float& alpha) {
    float pmax = p0[0]; for (int r = 1; r < 16; ++r) pmax = fmaxf(pmax, p0[r]); for (int r = 0; r < 16; ++r) pmax = fmaxf(pmax, p1[r]);
    { auto rr = __builtin_amdgcn_permlane32_swap(__float_as_uint(pmax), __float_as_uint(pmax), false, false);
      pmax = fmaxf(__uint_as_float(rr[0]), __uint_as_float(rr[1])); }
    constexpr float C2 = 1.4426950408889634f * SCALE;
    if (__builtin_expect(__all((pmax - m_reg) * SCALE <= THR), 1)) { mn = m_reg; alpha = 1.f; }
    else { mn = fmaxf(m_reg, pmax); alpha = __builtin_amdgcn_exp2f((m_reg - mn) * C2); m_reg = mn; }
    const float mnL = -mn * C2;
    for (int r = 0; r < 16; ++r) p0[r] = fmaf(p0[r], C2, mnL); for (int r = 0; r < 16; ++r) p1[r] = fmaf(p1[r], C2, mnL);
    for (int r = 0; r < 16; ++r) p0[r] = __builtin_amdgcn_exp2f(p0[r]);
}
__device__ __forceinline__ void finishSM(f32x16& p0, f32x16& p1, float alpha, float& l_reg, bf16x8& pa0, bf16x8& pa1, bf16x8& pa2, bf16x8& pa3) {
    for (int r = 0; r < 16; ++r) p1[r] = __builtin_amdgcn_exp2f(p1[r]);
    float ps = 0; for (int r = 0; r < 16; ++r) ps += p0[r]; for (int r = 0; r < 16; ++r) ps += p1[r];
    { auto rr = __builtin_amdgcn_permlane32_swap(__float_as_uint(ps), __float_as_uint(ps), false, false);
      ps = __uint_as_float(rr[0]) + __uint_as_float(rr[1]); }
    l_reg = l_reg * alpha + ps;
#define PK4(P, B_, OUT) do { unsigned a0 = cvtpk(P[B_+0], P[B_+1]), a1 = cvtpk(P[B_+2], P[B_+3]);                          \
        unsigned b0 = cvtpk(P[B_+4], P[B_+5]), b1 = cvtpk(P[B_+6], P[B_+7]);                                             \
        auto r0 = __builtin_amdgcn_permlane32_swap(a0, b0, false, false); auto r1 = __builtin_amdgcn_permlane32_swap(a1, b1, false, false); \
        u32x4 w = {r0[0], r1[0], r0[1], r1[1]}; OUT = *reinterpret_cast<bf16x8*>(&w); } while (0)
    PK4(p0, 0, pa0); PK4(p0, 8, pa1); PK4(p1, 0, pa2); PK4(p1, 8, pa3);
#undef PK4
}
template <int KB>
__device__ __forceinline__ void qkt(f32x16& p0, f32x16& p1, const char* K_lds, int r32, int hi, const bf16x8* qr) {
    p0 = f32x16{}; p1 = f32x16{};
    const char* kb[4];
#pragma unroll
    for (int dd = 0; dd < 4; ++dd) kb[dd] = K_lds + KB * SHM_K + KSWZ(r32, (dd * 16 + hi * 8) * 2);
#pragma unroll
    for (int d0 = 0; d0 < 8; ++d0) { const char* a = kb[d0 & 3] + (d0 >> 2) * 128;
        bf16x8 b0 = *reinterpret_cast<const bf16x8*>(a);
        bf16x8 b1 = *reinterpret_cast<const bf16x8*>(a + 32 * 256);
        p0 = __builtin_amdgcn_mfma_f32_32x32x16_bf16(b0, qr[d0], p0, 0, 0, 0);
        p1 = __builtin_amdgcn_mfma_f32_32x32x16_bf16(b1, qr[d0], p1, 0, 0, 0); }
}
template <int VB>
__device__ __forceinline__ void pv_tile(f32x16* o, int vb0, bf16x8 pa0, bf16x8 pa1, bf16x8 pa2, bf16x8 pa3) {
#define TRRD(dst, off) asm volatile("ds_read_b64_tr_b16 %0, %1 offset:%2" : "=&v"(dst) : "v"(vb0), "i"(off) : "memory")
#define PV_D0(d0) do { s16x4 l0, l1, l2, l3, h0, h1, h2, h3; constexpr int b_ = VB * SHM_V + v_rd_off(d0, 0, 0); \
        TRRD(l0, b_); TRRD(h0, b_ + 2048); TRRD(l1, b_ + 4096); TRRD(h1, b_ + 6144); TRRD(l2, b_ + 8192); TRRD(h2, b_ + 10240); TRRD(l3, b_ + 12288); TRRD(h3, b_ + 14336); \
        asm volatile("s_waitcnt lgkmcnt(0)" ::: "memory"); SBAR(); \
        o[d0] = __builtin_amdgcn_mfma_f32_32x32x16_bf16(pa0, (bf16x8){l0[0], l0[1], l0[2], l0[3], h0[0], h0[1], h0[2], h0[3]}, o[d0], 0, 0, 0);   \
        o[d0] = __builtin_amdgcn_mfma_f32_32x32x16_bf16(pa1, (bf16x8){l1[0], l1[1], l1[2], l1[3], h1[0], h1[1], h1[2], h1[3]}, o[d0], 0, 0, 0);   \
        o[d0] = __builtin_amdgcn_mfma_f32_32x32x16_bf16(pa2, (bf16x8){l2[0], l2[1], l2[2], l2[3], h2[0], h2[1], h2[2], h2[3]}, o[d0], 0, 0, 0);   \
        o[d0] = __builtin_amdgcn_mfma_f32_32x32x16_bf16(pa3, (bf16x8){l3[0], l3[1], l3[2], l3[3], h3[0], h3[1], h3[2], h3[3]}, o[d0], 0, 0, 0); } while (0)
    PV_D0(0); PV_D0(1); PV_D0(2); PV_D0(3);
#undef PV_D0
#undef TRRD
}

struct BlockRef { const bf16* Q; const bf16* K; const bf16* V; bf16* O; int P0; };
struct Seam { bf16x8 qr[8]; bf16x8 st_v0, st_v1, st_k0, st_k1; };
#define ROW(p, k0, rr) (((p) + (size_t)((k0) + (rr) - sr) * D) + toff)
#define VMW() asm volatile("s_waitcnt vmcnt(0)" ::: "memory")
#define VMWN(n) asm volatile("s_waitcnt vmcnt(%0)" :: "i"(n) : "memory")
#define SLOAD_H(Kp, Vp, k0) do { S.st_v0 = load8(ROW(Vp, k0, sr)); S.st_v1 = load8(ROW(Vp, k0, 32 + sr));              \
                         S.st_k0 = load8(ROW(Kp, k0, sr)); S.st_k1 = load8(ROW(Kp, k0, 32 + sr)); } while (0)
#define SWRITE_HK(bf) do { *(bf16x8*)(K_lds + (bf) * SHM_K + kws) = S.st_k0; *(bf16x8*)(K_lds + (bf) * SHM_K + kws + 32 * 256) = S.st_k1; } while (0)
#define SWRITE_HV(bf) do { *(bf16x8*)(V_lds + (bf) * SHM_V + vst0) = S.st_v0; *(bf16x8*)(V_lds + (bf) * SHM_V + vst1) = S.st_v1; } while (0)
#define SWRITE_H(bf) do { SWRITE_HV(bf); SWRITE_HK(bf); } while (0)
__device__ __forceinline__ void causal_prime(const BlockRef& cur, char* lds, Seam& S) {
    const int tid = opaque_tid(), wid = __builtin_amdgcn_readfirstlane(tid >> 6), lane = tid & 63, r32 = lane & 31, hi = lane >> 5;
    const int sr = tid >> 4, sc = (tid & 15) * 8, kws = KSWZ(sr, sc * 2); const unsigned toff = (unsigned)(sr * D + sc); char* K_lds = lds + 2 * SHM_V;
    for (int d0 = 0; d0 < 8; ++d0) S.qr[d0] = load8(cur.Q + (size_t)(wid * QBLK + r32) * D + d0 * 16 + hi * 8);
    SLOAD_H(cur.K, cur.V, 0); VMW(); SWRITE_HK(0);
    __syncthreads();
}
__device__ __forceinline__ void causal_block(const BlockRef& cur, const BlockRef& nxt, char* lds, Seam& S) {
    const int tid = opaque_tid(), wid = __builtin_amdgcn_readfirstlane(tid >> 6), lane = tid & 63, r32 = lane & 31, hi = lane >> 5;
    constexpr unsigned W = 0x40000000u;
    const int NT = (cur.P0 + QB - 1) / KVBLK + 1;
    const int qlo = cur.P0 + wid * QBLK, qm = qlo + r32 - 4 * hi;
    char* V_lds = lds; char* K_lds = lds + 2 * SHM_V;
    float* ws = (float*)(lds + LDS_WSF) + wid * 64; float* li_l = ws, * al_l = ws + 32;
    float* Fl = (float*)(lds + LDS_F);
    const float* Fk0 = Fl + 4 * hi;
    float m_reg = -1e30f, l_reg = 0; f32x16 o[4] = {};
    const int sr = tid >> 4, sc = (tid & 15) * 8, vst0 = v_st(sr, sc), vst1 = v_st(32 + sr, sc), kws = KSWZ(sr, sc * 2); const unsigned toff = (unsigned)(sr * D + sc);
    const int vb0 = (int)(uintptr_t)V_lds + v_rd_base(lane);
    const bf16* Kh = cur.K; const bf16* Vh = cur.V;
#define RESC(a) do { if (__any((a) < 1.f)) { if (hi == 0) al_l[r32] = (a); asm volatile("s_waitcnt lgkmcnt(0)" ::: "memory");              \
                     for (int d_ = 0; d_ < 4; ++d_) for (int r = 0; r < 16; ++r) o[d_][r] *= al_l[crow(r, hi)]; } } while (0)
#define KBASE(t) ((t) * KVBLK)
#define MASKT(P0_, P1_, t) do { const int kb_ = KBASE(t); bias_tile(P0_, P1_, Fk0 + kb_); if (kb_ + KVBLK - 1 > qlo) mask_tile(P0_, P1_, qm - kb_, W); } while (0)
    constexpr int NQL = 8;
#define SEAM_K0() do { VMWN(NQL); SWRITE_HK(0); SBAR(); } while (0)
    f32x16 pA0, pA1, pB0, pB1; float mnA, mnB, alA, alB; bf16x8 pa0, pa1, pa2, pa3;
    SWRITE_HV(0); SBAR();
    if (NT > 1) { SLOAD_H(Kh, Vh, KBASE(1)); }
    SBAR(); qkt<0>(pA0, pA1, K_lds, r32, hi, S.qr);
    MASKT(pA0, pA1, 0); partialSM(pA0, pA1, m_reg, mnA, alA);
    if (NT > 1) { VMW(); SWRITE_H(1); }
    __syncthreads();
#define HALF_STEP(PX0, PX1, mnX, alX, PY0, PY1, alY, t, KB, VB, SB) do {                                                      \
        SBAR(); qkt<KB>(PX0, PX1, K_lds, r32, hi, S.qr);                                             \
        finishSM(PY0, PY1, alY, l_reg, pa0, pa1, pa2, pa3); SBAR();                                                           \
        if ((t) + 1 < NT) { SLOAD_H(Kh, Vh, KBASE((t) + 1)); SBAR(); }                                               \
        pv_tile<VB>(o, vb0, pa0, pa1, pa2, pa3); MASKT(PX0, PX1, (t)); partialSM(PX0, PX1, m_reg, mnX, alX);                                        \
        __syncthreads();                                                                                                      \
        if ((t) + 1 < NT) { VMW(); SWRITE_H(SB); }                                                                          \
        RESC(alX); __syncthreads(); } while (0)
    for (int t = 1; t + 1 < NT; t += 2) {
        HALF_STEP(pB0, pB1, mnB, alB, pA0, pA1, alA, t, 1, 0, 0);
        HALF_STEP(pA0, pA1, mnA, alA, pB0, pB1, alB, t + 1, 0, 1, 1);
    }
    const bool even = (NT & 1) == 0;
    if (even) { SBAR(); qkt<1>(pB0, pB1, K_lds, r32, hi, S.qr); SBAR(); }
    SLOAD_H(nxt.K, nxt.V, 0); SBAR();
#pragma unroll
    for (int d0 = 0; d0 < 8; ++d0) S.qr[d0] = __builtin_nontemporal_load((const bf16x8*)(nxt.Q + (size_t)(wid * QBLK + r32) * D + d0 * 16 + hi * 8));
    SBAR();
    finishSM(pA0, pA1, alA, l_reg, pa0, pa1, pa2, pa3); SBAR();
    pv_tile<0>(o, vb0, pa0, pa1, pa2, pa3);
    if (even) { MASKT(pB0, pB1, NT - 1); partialSM(pB0, pB1, m_reg, mnB, alB); __syncthreads(); RESC(alB);
        finishSM(pB0, pB1, alB, l_reg, pa0, pa1, pa2, pa3); SBAR(); pv_tile<1>(o, vb0, pa0, pa1, pa2, pa3); }
    SBAR(); SEAM_K0();
    if (hi == 0) li_l[r32] = l_reg; asm volatile("s_waitcnt lgkmcnt(0)" ::: "memory");
    float rli[16];
#pragma unroll
    for (int r = 0; r < 16; ++r) rli[r] = __builtin_amdgcn_rcpf(li_l[crow(r, hi)]);
    bf16* Ow = cur.O + (size_t)(wid * QBLK) * OST;
#pragma unroll
    for (int r = 0; r < 16; ++r) { const int orow = crow(r, hi);
#pragma unroll
        for (int d0 = 0; d0 < 4; ++d0) { const float v = o[d0][r] * rli[r];
            const float vn = __shfl_xor(v, 1);
            if ((r32 & 1) == 0) *(unsigned*)(Ow + (size_t)orow * OST + d0 * 32 + r32) = cvtpk(v, vn); } }
    __syncthreads();
#undef RESC
#undef KBASE
#undef MASKT
#undef SEAM_K0
#undef HALF_STEP
}
#undef ROW
#undef VMW
#undef VMWN
#undef SLOAD_H
#undef SWRITE_HK
#undef SWRITE_HV
#undef SWRITE_H

__device__ __forceinline__ void fcumsum_lds(const unsigned char* ws, float* Fl, float* scr, int bh, int tid) {
    const int b = bh >> 3, h = bh & 7, lane = tid & 63, wave = tid >> 6;
    const float* lf = (const float*)(ws + WS_LF) + (size_t)b * SEQ * 8 + h;
    float v[8]; float s = 0.f;
#pragma unroll
    for (int i = 0; i < 8; ++i) { s += lf[(size_t)(tid * 8 + i) * 8]; v[i] = s; }
    float incl = s;
#pragma unroll
    for (int o = 1; o < 64; o <<= 1) { const float t = __shfl_up(incl, o); if (lane >= o) incl += t; }
    __syncthreads();
    if (lane == 63) scr[wave] = incl;
    __syncthreads();
    float pre = incl - s;
    for (int w = 0; w < wave; ++w) pre += scr[w];
    const float isc = 11.313708498984761f;
#pragma unroll
    for (int i = 0; i < 8; ++i) Fl[tid * 8 + i] = (pre + v[i]) * isc;
    __syncthreads();
}

__device__ __forceinline__ BlockRef make_ref(int bh, int qb, const unsigned char* ws_c, unsigned char* ws) {
    BlockRef r; const int b = bh >> 3, h = bh & 7;
    const size_t off = ((size_t)bh * SEQ + (size_t)qb * QB) * D;
    r.Q = (const bf16*)(ws_c + WS_FQ) + off; r.K = (const bf16*)(ws_c + WS_FK) + (size_t)bh * SEQ * D; r.V = (const bf16*)(ws_c + WS_FV) + (size_t)bh * SEQ * D;
    r.O = (bf16*)(ws + WS_YF) + ((size_t)(b * SEQ + qb * QB)) * OST + h * D;
    r.P0 = qb * QB; return r;
}
__device__ __forceinline__ void attn_phase(char* lds, unsigned char* ws, int first, int stride) {
    constexpr int NITEMS = 128;
    int L = first; if (L >= NITEMS) return;
    int bh = L >> 3, x = L & 7, pass = 0;
    BlockRef cur = make_ref(bh, x, ws, ws);
    Seam S;
    causal_prime(cur, lds, S);
    int bh_cur = bh, bh_loaded = -1;
    for (;;) {
        if (bh_cur != bh_loaded) { fcumsum_lds(ws, (float*)(lds + LDS_F), (float*)(lds + LDS_AUX), bh_cur, (int)threadIdx.x); bh_loaded = bh_cur; }
        const bool more_pass = pass == 0, more_item = L + stride < NITEMS, last = !more_pass && !more_item;
        int Ln = L, passn = pass + 1;
        if (!more_pass) { passn = 0; Ln = more_item ? L + stride : L; }
        const int bhn = Ln >> 3, xn = Ln & 7, qbn = passn ? 15 - xn : xn;
        const BlockRef nxt = last ? cur : make_ref(bhn, qbn, ws, ws);
        causal_block(cur, nxt, lds, S);
        if (last) break;
        cur = nxt; pass = passn; L = Ln; bh_cur = bhn;
    }
}
#undef KSWZ
#undef SBAR
}

#define LAS __attribute__((address_space(3)))
typedef unsigned short bf16;
typedef unsigned v4u __attribute__((ext_vector_type(4)));
typedef unsigned v2u __attribute__((ext_vector_type(2)));
typedef float f32x4 __attribute__((ext_vector_type(4)));
typedef float f32x2 __attribute__((ext_vector_type(2)));
typedef short bf16x8 __attribute__((ext_vector_type(8)));

constexpr int TR_SLOT = 16896;
struct TrDesc { const float* W; bf16* WT; const float* gain; int K, ld, c0, nblk, row0, sw, item, valid, dK, dk0; };
__device__ __forceinline__ void tr_load(const TrDesc& d, f32x4 (&v)[16], int lane) {
    const int kb = d.item / d.nblk, nb = d.item % d.nblk, k0 = 64 * kb, n0 = 64 * nb, q = lane >> 4, l15 = lane & 15;
    const float* src = d.W + (size_t)(k0 + q) * d.ld + d.c0 + n0 + 4 * l15;
#pragma unroll
    for (int i = 0; i < 16; ++i) v[i] = __builtin_nontemporal_load((const f32x4*)(src + (size_t)(4 * i) * d.ld));
}
__device__ __forceinline__ void tr_process(const TrDesc& d, f32x4 (&v)[16], float* scr, int lane) {
    const int kb = d.item / d.nblk, nb = d.item % d.nblk, k0 = 64 * kb, n0 = 64 * nb, q = lane >> 4, l15 = lane & 15;
    if (d.gain) {
#pragma unroll
        for (int i = 0; i < 16; ++i) v[i] = v[i] * d.gain[k0 + 4 * i + q];
    }
#pragma unroll
    for (int i = 0; i < 16; ++i) { float* p = scr + (4 * i + q) * 65 + 4 * l15; p[0] = v[i].x; p[1] = v[i].y; p[2] = v[i].z; p[3] = v[i].w; }
    asm volatile("s_waitcnt lgkmcnt(0)" ::: "memory");
    const int c = lane & 7;
    const int drow0 = d.sw ? (256 * (n0 >> 7) + 128 * (d.sw - 1) + (n0 & 127)) : (d.row0 + n0);
#pragma unroll
    for (int j = 0; j < 8; ++j) { const int n = (lane >> 3) + 8 * j; const float* s = scr + (8 * c) * 65 + n;
        v4u o; o.x = pk2(s[0 * 65], s[1 * 65]); o.y = pk2(s[2 * 65], s[3 * 65]); o.z = pk2(s[4 * 65], s[5 * 65]); o.w = pk2(s[6 * 65], s[7 * 65]);
        *(v4u*)(d.WT + (size_t)(drow0 + n) * d.dK + d.dk0 + k0 + 8 * c) = o; }
    asm volatile("s_waitcnt lgkmcnt(0)" ::: "memory");
}

template <bool OUTF32>
__device__ __forceinline__ void rms_row(const float* xrow, const float* gain, void* orow, int lane) {
    const f32x4* xr = (const f32x4*)xrow + lane;
    f32x4 v[8]; float s = 0.f;
#pragma unroll
    for (int j = 0; j < 8; ++j) { v[j] = xr[64 * j]; s += (v[j].x * v[j].x + v[j].y * v[j].y) + (v[j].z * v[j].z + v[j].w * v[j].w); }
    const float rstd = __builtin_amdgcn_rsqf(wave_sum(s) * (1.0f / DM) + EPS);
#pragma unroll
    for (int j = 0; j < 8; ++j) { const f32x4 g = ((const f32x4*)gain)[lane + 64 * j]; const f32x4 y = v[j] * rstd * g;
        if constexpr (OUTF32) ((f32x4*)orow)[lane + 64 * j] = y;
        else { v2u w; w.x = pk2(y.x, y.y); w.y = pk2(y.z, y.w); ((v2u*)orow)[lane + 64 * j] = w; } }
}

template <int SET>
__device__ __forceinline__ TrDesc tr_resolve(const Args& a, int it) {
    unsigned char* ws = a.ws; TrDesc d; d.valid = 0; d.W = nullptr; d.WT = nullptr; d.gain = nullptr; d.K = d.ld = d.c0 = d.nblk = d.row0 = d.sw = d.item = d.dK = d.dk0 = 0;
    int r = it;
#define SEG(Wp, K_, LD_, C0_, NC_, DST_, R0_, SW_, GAIN_) if (!d.valid) { constexpr int ni_ = ((K_) / 64) * ((NC_) / 64); if (r < ni_) { d.W = Wp; d.WT = (bf16*)(ws + (DST_)); d.gain = GAIN_; d.K = K_; d.ld = LD_; d.c0 = C0_; d.nblk = (NC_) / 64; d.row0 = R0_; d.sw = SW_; d.item = r; d.valid = 1; d.dK = K_; d.dk0 = 0; } else r -= ni_; }
    if constexpr (SET == 0) {
        SEG(a.in[3], DM, DFF, 0, DFF, WS_WGU1, 0, 1, a.in[2])
        SEG(a.in[4], DM, DFF, 0, DFF, WS_WGU1, 0, 2, a.in[2])
        SEG(a.in[22], PLE, DM, 0, DM, WS_WPE, 0, 0, nullptr)
    } else if constexpr (SET == 1) {
        SEG(a.in[5], DFF, DM, 0, DM, WS_WD1, 0, 0, nullptr)
        SEG(a.in[7], DM, DIN, 0, 3072, WS_W4, 0, 0, a.in[6])
        SEG(a.in[7], DM, DIN, 3080, 3072, WS_W4, 3072, 0, a.in[6])
        SEG(a.in[14], DM, 4096, 0, 4096, WS_W4, 6144, 0, a.in[6])
    } else if constexpr (SET == 3) {
        SEG(a.in[18], DM, DFF, 0, DFF, WS_WGU2, 0, 1, a.in[17])
        SEG(a.in[19], DM, DFF, 0, DFF, WS_WGU2, 0, 2, a.in[17])
        SEG(a.in[12], 1024, DM, 0, DM, WS_WA, 0, 0, nullptr) if (d.valid && d.W == a.in[12]) { d.dK = 2048; }
        SEG(a.in[13], 1024, DM, 0, DM, WS_WA, 0, 0, nullptr) if (d.valid && d.W == a.in[13]) { d.dK = 2048; d.dk0 = 1024; }
        SEG(a.in[16], DM, DM, 0, DM, WS_WOUT, 0, 0, nullptr)
    } else {
        SEG(a.in[20], DFF, DM, 0, DM, WS_WD2, 0, 0, nullptr)
        SEG(a.in[23], DM, DM, 0, DM, WS_WPG, 0, 0, a.in[21])
    }
#undef SEG
    return d;
}
template <int SET>
__device__ __forceinline__ void convert_set(const Args& a, unsigned char* lds, int w, int NW, int wave, int lane) {
    float* scr = (float*)(lds + wave * TR_SLOT);
    f32x4 vA[16], vB[16];
    int it = w;
    TrDesc dA = tr_resolve<SET>(a, it), dB;
    if (dA.valid) tr_load(dA, vA, lane);
    while (dA.valid) {
        dB = tr_resolve<SET>(a, it + NW); if (dB.valid) tr_load(dB, vB, lane);
        tr_process(dA, vA, scr, lane);
        if (!dB.valid) break;
        it += 2 * NW;
        dA = tr_resolve<SET>(a, it); if (dA.valid) tr_load(dA, vA, lane);
        tr_process(dB, vB, scr, lane);
    }
}
constexpr int NCONV = 21;
__device__ __forceinline__ void p0_prologue(const Args& a, unsigned char* lds, int gw, int NGW, int wave, int lane) {
    unsigned char* ws = a.ws;
    convert_set<0>(a, lds, gw, NGW, wave, lane);
    { float* wsm = (float*)(ws + WS_WSM); const float* win = a.in[7];
        for (int i = gw * 64 + lane; i < 24 * DM; i += NGW * 64) { const int c = i % 24, k = i / 24; wsm[(size_t)c * DM + k] = win[(size_t)k * DIN + (c < 8 ? 3072 + c : 6152 + (c - 8))]; } }
    { float* q = (float*)(ws + WS_SSQ); for (int i = gw * 64 + lane; i < 4 * T; i += NGW * 64) q[i] = 0.f; }
    for (int m = gw; m < T; m += NGW) {
        const f32x4* xr = (const f32x4*)(a.in[0] + (size_t)m * DM) + lane; v2u* o = (v2u*)((bf16*)(ws + WS_XN) + (size_t)m * DM);
        f32x4 v[8]; float sq = 0.f;
#pragma unroll
        for (int j = 0; j < 8; ++j) { v[j] = __builtin_nontemporal_load(xr + 64 * j); sq += (v[j].x * v[j].x + v[j].y * v[j].y) + (v[j].z * v[j].z + v[j].w * v[j].w); }
        sq = wave_sum(sq);
#pragma unroll
        for (int j = 0; j < 8; ++j) { v2u w; w.x = pk2(v[j].x, v[j].y); w.y = pk2(v[j].z, v[j].w); o[lane + 64 * j] = w; }
        if (lane == 0) ((float*)(ws + WS_SSQ))[4 * T + m] = sq;
    }
    { const f32x4* p = (const f32x4*)a.in[1]; v2u* o = (v2u*)(ws + WS_PB);
        for (int i = gw * 64 + lane; i < T * PLE / 4; i += NGW * 64) { const f32x4 v = __builtin_nontemporal_load(p + i); v2u w; w.x = pk2(v.x, v.y); w.y = pk2(v.z, v.w); o[i] = w; } }
}

__device__ __forceinline__ void p3_rows(const Args& a, const float* H, unsigned char* lds, int bx, int G, int tid) {
    constexpr int NR = 4;
    unsigned char* ws = a.ws;
    const int lane = tid & 63, wave = tid >> 6;
    const f32x4* wsm4 = (const f32x4*)(ws + WS_WSM);
    f32x4* wl = (f32x4*)lds;
    f32x4* gul = (f32x4*)(lds + 98304);
    { const f32x4* gu = (const f32x4*)a.in[9];
#pragma unroll
      for (int i = 0; i < 4; ++i) gul[tid + 512 * i] = gu[tid + 512 * i]; }
    for (int it = bx; it < T / (8 * NR); it += G) {
        const int m0 = it * (8 * NR) + wave * NR;
        f32x4 u[NR][8];
#pragma unroll
        for (int r = 0; r < NR; ++r) {
            const v2u* xr = (const v2u*)((const bf16*)H + (size_t)(m0 + r) * DM) + lane; float s = 0.f;
#pragma unroll
            for (int j = 0; j < 8; ++j) { const v2u w = xr[64 * j]; u[r][j] = (f32x4){__builtin_bit_cast(float, w.x << 16), __builtin_bit_cast(float, w.x & 0xffff0000u), __builtin_bit_cast(float, w.y << 16), __builtin_bit_cast(float, w.y & 0xffff0000u)}; s += (u[r][j].x * u[r][j].x + u[r][j].y * u[r][j].y) + (u[r][j].z * u[r][j].z + u[r][j].w * u[r][j].w); }
            const float rstd = __builtin_amdgcn_rsqf(wave_sum(s) * (1.0f / DM) + EPS);
#pragma unroll
            for (int j = 0; j < 8; ++j) { const f32x4 g = ((const f32x4*)a.in[6])[lane + 64 * j]; u[r][j] = u[r][j] * rstd * g; }
        }
        float mine[NR];
#pragma unroll
        for (int r = 0; r < NR; ++r) mine[r] = 0.f;
        for (int half = 0; half < 2; ++half) {
            __syncthreads();
#pragma unroll 4
            for (int i = 0; i < 12; ++i) wl[tid + 512 * i] = wsm4[(size_t)half * 6144 + tid + 512 * i];
            __syncthreads();
            for (int c = 0; c < 12; ++c) {
                const f32x4* wr = wl + c * 512 + lane;
                float d[NR];
#pragma unroll
                for (int r = 0; r < NR; ++r) d[r] = 0.f;
#pragma unroll
                for (int j = 0; j < 8; ++j) { const f32x4 w = wr[64 * j];
#pragma unroll
                    for (int r = 0; r < NR; ++r) d[r] += (u[r][j].x * w.x + u[r][j].y * w.y) + (u[r][j].z * w.z + u[r][j].w * w.w); }
#pragma unroll
                for (int r = 0; r < NR; ++r) d[r] = wave_sum(d[r]);
                if (lane == half * 12 + c) {
#pragma unroll
                    for (int r = 0; r < NR; ++r) mine[r] = d[r]; }
            }
        }
        if (lane < 8) { const float fb = a.in[8][lane]; float* lf = (float*)(ws + WS_LF);
#pragma unroll
            for (int r = 0; r < NR; ++r) lf[(size_t)(m0 + r) * 8 + lane] = logsigmoid_f(mine[r] + fb); }
        { const f32x4 b0 = ((const f32x4*)a.in[10])[lane * 2], b1 = ((const f32x4*)a.in[10])[lane * 2 + 1];
          float* la = (float*)(ws + WS_LA);
#pragma unroll
          for (int rp = 0; rp < NR; rp += 2) {
            f32x4 acc[2][2];
            acc[0][0] = b0; acc[0][1] = b1; acc[1][0] = b0; acc[1][1] = b1;
#pragma unroll
            for (int k = 0; k < RANK; ++k) { const f32x4 g0 = gul[k * 128 + lane * 2], g1 = gul[k * 128 + lane * 2 + 1];
                const float gd0 = __shfl(mine[rp], 8 + k), gd1 = __shfl(mine[rp + 1], 8 + k);
                acc[0][0] += gd0 * g0; acc[0][1] += gd0 * g1; acc[1][0] += gd1 * g0; acc[1][1] += gd1 * g1; }
#pragma unroll
            for (int r = 0; r < 2; ++r) { f32x4 o0, o1;
#pragma unroll
                for (int i = 0; i < 4; ++i) { o0[i] = logsigmoid_f(acc[r][0][i]) * (1.0f / 16.0f); o1[i] = logsigmoid_f(acc[r][1][i]) * (1.0f / 16.0f); }
                ((f32x4*)(la + (size_t)(m0 + rp + r) * 512))[lane * 2] = o0; ((f32x4*)(la + (size_t)(m0 + rp + r) * 512))[lane * 2 + 1] = o1; } } }
    }
    __syncthreads();
}

constexpr int GL_KD = 0, GL_VT = 128 * 144, GL_TOT = GL_VT + 256 * 144, GL_END = GL_TOT + 4 * 128 * 4;
__device__ __forceinline__ void gla_g1(unsigned char* ws, unsigned char* lds, int unit, int tid) {
    const int bh = unit >> 6, c = unit & 63, b = bh >> 2, h = bh & 3, lane = tid & 63, wave = tid >> 6;
    const size_t t0 = (size_t)b * SEQ + (size_t)c * CHUNK;
    {
        const int ch = tid & 127, fg = tid >> 7;
        const float* la = (const float*)(ws + WS_LA) + (t0 + 16 * fg) * 512 + h * 128 + ch;
        const bf16* kp = (const bf16*)(ws + WS_GK) + (t0 + 16 * fg) * 512 + h * 128 + ch;
        const bf16* vp = (const bf16*)(ws + WS_GV) + t0 * 1024 + h * 256;
        float ac[16]; bf16 kr[16]; v4u vw[4];
#pragma unroll
        for (int f = 0; f < 16; ++f) ac[f] = la[(size_t)f * 512];
#pragma unroll
        for (int f = 0; f < 16; ++f) kr[f] = kp[(size_t)f * 512];
#pragma unroll
        for (int i = 0; i < 4; ++i) { const int idx = tid + 512 * i, f = idx & 63, v8 = (idx >> 6) * 8; vw[i] = *(const v4u*)(vp + (size_t)f * 1024 + v8); }
        float s = 0.f;
#pragma unroll
        for (int f = 0; f < 16; ++f) { s += ac[f]; ac[f] = s; }
        float* tot = (float*)(lds + GL_TOT);
        tot[fg * 128 + ch] = s;
#pragma unroll
        for (int i = 0; i < 4; ++i) { const int idx = tid + 512 * i, f = idx & 63, v8 = (idx >> 6) * 8; const v4u w = vw[i];
            bf16* d = (bf16*)(lds + GL_VT) + f;
            d[(v8 + 0) * 72] = (bf16)(w.x & 0xffff); d[(v8 + 1) * 72] = (bf16)(w.x >> 16); d[(v8 + 2) * 72] = (bf16)(w.y & 0xffff); d[(v8 + 3) * 72] = (bf16)(w.y >> 16);
            d[(v8 + 4) * 72] = (bf16)(w.z & 0xffff); d[(v8 + 5) * 72] = (bf16)(w.z >> 16); d[(v8 + 6) * 72] = (bf16)(w.w & 0xffff); d[(v8 + 7) * 72] = (bf16)(w.w >> 16); }
        __syncthreads();
        float pre = 0.f, all = 0.f;
#pragma unroll
        for (int g = 0; g < 4; ++g) { const float tg = tot[g * 128 + ch]; all += tg; if (g < fg) pre += tg; }
        if (fg == 0) ((float*)(ws + WS_DEC))[(size_t)unit * 128 + ch] = __expf(all);
        unsigned pk[8];
#pragma unroll
        for (int f = 0; f < 16; f += 2) { const float k0 = bf2f(kr[f]) * __expf(all - (pre + ac[f])), k1 = bf2f(kr[f + 1]) * __expf(all - (pre + ac[f + 1])); pk[f >> 1] = pk2(k0, k1); }
        v4u* dst = (v4u*)(lds + GL_KD + ch * 144 + fg * 32);
        dst[0] = (v4u){pk[0], pk[1], pk[2], pk[3]}; dst[1] = (v4u){pk[4], pk[5], pk[6], pk[7]};
    }
    __syncthreads();
    { const int l15 = lane & 15, quad = lane >> 4;
        bf16x8 af[2][2];
#pragma unroll
        for (int mt = 0; mt < 2; ++mt)
#pragma unroll
            for (int kk = 0; kk < 2; ++kk) af[mt][kk] = *(const bf16x8*)(lds + GL_VT + (32 * wave + 16 * mt + l15) * 144 + kk * 64 + quad * 16);
        float* out = (float*)(ws + WS_KV) + (size_t)unit * 256 * 128;
#pragma unroll
        for (int nt = 0; nt < 8; ++nt) {
            const bf16x8 b0 = *(const bf16x8*)(lds + GL_KD + (16 * nt + l15) * 144 + quad * 16), b1 = *(const bf16x8*)(lds + GL_KD + (16 * nt + l15) * 144 + 64 + quad * 16);
#pragma unroll
            for (int mt = 0; mt < 2; ++mt) { f32x4 acc = {0.f, 0.f, 0.f, 0.f};
                acc = __builtin_amdgcn_mfma_f32_16x16x32_bf16(af[mt][0], b0, acc, 0, 0, 0);
                acc = __builtin_amdgcn_mfma_f32_16x16x32_bf16(af[mt][1], b1, acc, 0, 0, 0);
#pragma unroll
                for (int j = 0; j < 4; ++j) out[(size_t)(32 * wave + 16 * mt + quad * 4 + j) * 128 + 16 * nt + l15] = acc[j]; }
        }
    }
    __syncthreads();
}
__device__ __forceinline__ void gla_g2(unsigned char* ws, int gtid, int gthreads) {
    const float* kv = (const float*)(ws + WS_KV); const float* dec = (const float*)(ws + WS_DEC); bf16* st = (bf16*)(ws + WS_XN);
    for (int e = gtid; e < 8 * 256 * 32; e += gthreads) {
        const int bh = e >> 13, vv = (e >> 5) & 255, ch = (e & 31) * 4;
        const float* kp = kv + ((size_t)bh * 64 * 256 + vv) * 128 + ch; const float* dp = dec + (size_t)bh * 64 * 128 + ch; bf16* sp = st + ((size_t)bh * 64 * 256 + vv) * 128 + ch;
        f32x4 s = {0.f, 0.f, 0.f, 0.f};
#pragma unroll 16
        for (int c = 0; c < NCH; ++c) {
            const f32x4 k = __builtin_nontemporal_load((const f32x4*)(kp + (size_t)c * 256 * 128)), d = *(const f32x4*)(dp + (size_t)c * 128);
            s = d * s + k;
            v2u w; w.x = pk2(s.x, s.y); w.y = pk2(s.z, s.w);
            *(v2u*)(sp + (size_t)c * 256 * 128) = w; }
    }
}
__device__ __forceinline__ void gla_g3(const Args& a, unsigned char* lds, int unit, int tid) {
    unsigned char* ws = a.ws;
    const int bh = unit >> 6, c = unit & 63, b = bh >> 2, h = bh & 3, lane = tid & 63, wave = tid >> 6, l15 = lane & 15, quad = lane >> 4;
    const size_t t0 = (size_t)b * SEQ + (size_t)c * CHUNK;
    const bf16* q = (const bf16*)(ws + WS_GQ) + t0 * 512 + h * 128;
    const bf16* st = (const bf16*)(ws + WS_XN) + (size_t)unit * 256 * 128;
    f32x4 acc[4][2];
#pragma unroll
    for (int mt = 0; mt < 4; ++mt) { acc[mt][0] = (f32x4){0.f, 0.f, 0.f, 0.f}; acc[mt][1] = (f32x4){0.f, 0.f, 0.f, 0.f}; }
#pragma unroll
    for (int kk = 0; kk < 4; ++kk) {
        bf16x8 bf[2];
#pragma unroll
        for (int nt = 0; nt < 2; ++nt) bf[nt] = __builtin_nontemporal_load((const bf16x8*)(st + (size_t)(32 * wave + 16 * nt + l15) * 128 + kk * 32 + quad * 8));
#pragma unroll
        for (int mt = 0; mt < 4; ++mt) { const bf16x8 af = *(const bf16x8*)(q + (size_t)(16 * mt + l15) * 512 + kk * 32 + quad * 8);
            acc[mt][0] = __builtin_amdgcn_mfma_f32_16x16x32_bf16(af, bf[0], acc[mt][0], 0, 0, 0);
            acc[mt][1] = __builtin_amdgcn_mfma_f32_16x16x32_bf16(af, bf[1], acc[mt][1], 0, 0, 0); }
    }
    float* ssq = (float*)lds;
    const float sc = 0.08838834764831845f;
#pragma unroll
    for (int mt = 0; mt < 4; ++mt)
#pragma unroll
        for (int j = 0; j < 4; ++j) { acc[mt][0][j] *= sc; acc[mt][1][j] *= sc;
            float s = acc[mt][0][j] * acc[mt][0][j] + acc[mt][1][j] * acc[mt][1][j];
            s += __shfl_xor(s, 1); s += __shfl_xor(s, 2); s += __shfl_xor(s, 4); s += __shfl_xor(s, 8);
            if (l15 == 0) ssq[wave * 64 + 16 * mt + 4 * quad + j] = s; }
    __syncthreads();
    const float* hn = a.in[11];
    const float g0 = hn[32 * wave + l15], g1 = hn[32 * wave + 16 + l15];
    const bf16* sgr = (const bf16*)(ws + WS_SGR) + t0 * 1024 + h * 256 + 32 * wave + l15;
    bf16* yg = (bf16*)(ws + WS_YF) + t0 * 2048 + 1024 + h * 256 + 32 * wave + l15;
#pragma unroll
    for (int mt = 0; mt < 4; ++mt)
#pragma unroll
        for (int j = 0; j < 4; ++j) { const int f = 16 * mt + 4 * quad + j; float tot = 0.f;
#pragma unroll
            for (int w = 0; w < 8; ++w) tot += ssq[w * 64 + f];
            const float rstd = __builtin_amdgcn_rsqf(tot * (1.0f / GVD) + EPS);
            yg[(size_t)f * 2048] = (bf16)f2bf(acc[mt][0][j] * rstd * g0 * bf2f(sgr[(size_t)f * 1024]));
            yg[(size_t)f * 2048 + 16] = (bf16)f2bf(acc[mt][1][j] * rstd * g1 * bf2f(sgr[(size_t)f * 1024 + 16])); }
    __syncthreads();
}

#define RLX_AGENT __ATOMIC_RELAXED, __HIP_MEMORY_SCOPE_AGENT
#define XB_TMO      128
#define XB_XCNT(j)  (256  + 64 * (j))
#define XB_XSUB(j)  (1280 + 64 * (j))
#define XB_XGEN(j)  (2304 + 64 * (j))
#define XB_TOP      3328
#define XB_TOPGEN   3392
#define XCD_BAR_WORDS 3456
#define XB_SPIN_CAP (1u << 18)

__device__ __forceinline__ unsigned xb_ld(unsigned* p)              { return __hip_atomic_load(p, __ATOMIC_RELAXED, __HIP_MEMORY_SCOPE_AGENT); }
__device__ __forceinline__ unsigned xb_add(unsigned* p, unsigned v) { return __hip_atomic_fetch_add(p, v, __ATOMIC_RELAXED, __HIP_MEMORY_SCOPE_AGENT); }
__device__ __forceinline__ unsigned xb_xcc_id() { return (unsigned)__builtin_amdgcn_s_getreg((3 << 11) | 20) & 0xFu; }
#define XB_SPIN(cond, bar) do { unsigned _sp = 0; while (cond) { __builtin_amdgcn_s_sleep(1); \
    if ((++_sp & 255u) == 0u) { if (xb_ld(&(bar)[XB_TMO])) break; if (_sp > XB_SPIN_CAP) { atomicAdd(&(bar)[XB_TMO], 1u); break; } } } } while (0)

struct XcdBarrier {
    unsigned* bar; unsigned x;
    volatile LAS unsigned* st;
};

__device__ __forceinline__ XcdBarrier xcd_barrier_post(unsigned* bar, volatile LAS unsigned* st) {
    XcdBarrier b; b.bar = bar; b.x = xb_xcc_id(); b.st = st;
    if (threadIdx.x == 0) (void)xb_add(&bar[XB_XCNT(b.x)], 1u);
    return b;
}
__device__ __forceinline__ void xcd_barrier_complete(unsigned* bar, unsigned x, unsigned& nloc, unsigned& nx) {
    const unsigned G = gridDim.x * gridDim.y * gridDim.z;
    unsigned sum, cnt, mine, sp = 0u;
    for (;;) {
        sum = 0u; cnt = 0u; mine = 0u;
#pragma unroll
        for (unsigned j = 0; j < 16; ++j) { const unsigned c = xb_ld(&bar[XB_XCNT(j)]); sum += c; cnt += (c > 0u) ? 1u : 0u; mine = (j == x) ? c : mine; }
        if (sum == G) break;
        __builtin_amdgcn_s_sleep(1);
        if ((++sp & 255u) == 0u) { if (xb_ld(&bar[XB_TMO])) break; if (sp > XB_SPIN_CAP) { atomicAdd(&bar[XB_TMO], 1u); break; } }
    }
    nloc = mine > 0u ? mine : 1u; nx = cnt > 0u ? cnt : 1u;
}

__device__ __forceinline__ void xcd_barrier(const XcdBarrier& b) {
    asm volatile("s_waitcnt vmcnt(0)" ::: "memory");
    __syncthreads();
    if (threadIdx.x == 0) {
        unsigned* bar = b.bar;
        __builtin_amdgcn_s_waitcnt(0);
        unsigned nloc = b.st[0], nx = b.st[1];
        if (nloc == 0u) { xcd_barrier_complete(bar, b.x, nloc, nx); b.st[0] = nloc; b.st[1] = nx; }
        const unsigned old = xb_add(&bar[XB_XSUB(b.x)], 1u);
        const unsigned gen = old / nloc;
        if (old + 1u == (gen + 1u) * nloc) {
            __builtin_amdgcn_fence(__ATOMIC_RELEASE, "agent");
            asm volatile("s_waitcnt vmcnt(0)" ::: "memory");
            const unsigned og = xb_add(&bar[XB_TOP], 1u);
            const unsigned tg = og / nx;
            if (og + 1u == (tg + 1u) * nx) xb_add(&bar[XB_TOPGEN], 1u);
            else XB_SPIN(xb_ld(&bar[XB_TOPGEN]) == tg, bar);
            __builtin_amdgcn_fence(__ATOMIC_ACQUIRE, "agent");
            xb_add(&bar[XB_XGEN(b.x)], 1u);
            asm volatile("s_waitcnt vmcnt(0)" ::: "memory");
        } else {
            XB_SPIN(xb_ld(&bar[XB_XGEN(b.x)]) == gen, bar);
            __builtin_amdgcn_fence(__ATOMIC_ACQUIRE, "agent");
            asm volatile("s_waitcnt vmcnt(0)" ::: "memory");
        }
    }
    __syncthreads();
}

__device__ __forceinline__ void sub_barrier(unsigned* ctr, unsigned target) {
    asm volatile("s_waitcnt vmcnt(0)" ::: "memory");
    __syncthreads();
    if (threadIdx.x == 0) {
        __builtin_amdgcn_fence(__ATOMIC_RELEASE, "agent");
        asm volatile("s_waitcnt vmcnt(0)" ::: "memory");
        (void)__hip_atomic_fetch_add(ctr, 1u, __ATOMIC_RELAXED, __HIP_MEMORY_SCOPE_AGENT);
        unsigned sp = 0;
        while (__hip_atomic_load(ctr, __ATOMIC_RELAXED, __HIP_MEMORY_SCOPE_AGENT) < target) { __builtin_amdgcn_s_sleep(2); if (++sp > (1u << 22)) break; }
        __builtin_amdgcn_fence(__ATOMIC_ACQUIRE, "agent");
        asm volatile("s_waitcnt vmcnt(0)" ::: "memory");
    }
    __syncthreads();
}

__global__ void __launch_bounds__(512, 2) fwd_kernel(Args a_unused) {
    extern __shared__ __attribute__((aligned(16))) unsigned char lds[];
    cg::grid_group grid = cg::this_grid();
    LAS unsigned char* ldsg = (LAS unsigned char*)lds;
    volatile LAS unsigned* bst = (volatile LAS unsigned*)(ldsg + LDS_AUX + 4096);
    if (threadIdx.x < 2) bst[threadIdx.x] = 0u;
    __syncthreads();
    const XcdBarrier xbar = xcd_barrier_post((unsigned*)((const Args*)__builtin_amdgcn_kernarg_segment_ptr())->ws + WS_BAR / 4, bst);
    typedef const __attribute__((address_space(4))) Args* kargp;
    kargp kap = (kargp)__builtin_amdgcn_kernarg_segment_ptr();
#define FRESH() asm volatile("" : "+s"(kap)); const Args a = *(const Args*)kap; unsigned char* ws = a.ws; float* H = a.out; (void)ws; (void)H; \
    const int tid = opaque_tid(), lane = tid & 63, wave = __builtin_amdgcn_readfirstlane(tid >> 6), G = gridDim.x, bx = blockIdx.x, gw = bx * 8 + wave, NGW = G * 8; (void)lane; (void)gw; (void)NGW;

    {   FRESH()
    p0_prologue(a, lds, gw, NGW, wave, lane);
    }
    if (gridDim.y == 0x7fffu) grid.sync();
    xcd_barrier(xbar);
    {   FRESH()
    { const int Gg = (G > 4 * NCONV) ? G - NCONV : G;
      if (bx < Gg) {
      pg8::Gemm g{(const bf16*)(ws + WS_XN), (const bf16*)(ws + WS_WGU1), T, 2 * DFF, DM}; pg8::StaticOrder S; S.init(T, 2 * DFF, Gg, bx);
      pg8::Epi<pg8::EPI_SWIGLU> E{}; E.dstb = (bf16*)(ws + WS_ACT); E.rs = (const float*)(ws + WS_SSQ) + 4 * T;
      pg8::gemm_phase<pg8::Epi<pg8::EPI_SWIGLU>, pg8::StaticOrder, true, true>(ldsg, g, S, E); }
      if (Gg == G) convert_set<1>(a, lds, gw, NGW, wave, lane);
      else if (bx >= Gg) convert_set<1>(a, lds, (bx - Gg) * 8 + wave, (G - Gg) * 8, wave, lane); }
    }
    xcd_barrier(xbar);
    {   FRESH()
    { pg8::Gemm g{(const bf16*)(ws + WS_ACT), (const bf16*)(ws + WS_WD1), T, DM, DFF}; pg8::StaticOrder S; S.init(T, DM, G, bx);
      pg8::Epi<pg8::EPI_RES> E{}; E.srcb = (const bf16*)(ws + WS_XN); E.dstf = nullptr; E.alpha = 0.5f; E.dstb = (bf16*)H; E.ssq = (float*)(ws + WS_SSQ);
      pg8::gemm_phase<pg8::Epi<pg8::EPI_RES>, pg8::StaticOrder, true, true>(ldsg, g, S, E); }
    }
    xcd_barrier(xbar);
    {   FRESH()
    p3_rows(a, H, lds, bx, G, tid);
    { pg8::Gemm g{(const bf16*)H, (const bf16*)(ws + WS_W4), T, N4, DM}; pg8::StaticOrder S; S.init(T, N4, G, bx);
      pg8::Epi<pg8::EPI_P4> E{}; E.ws = ws; E.bias = a.in[15]; E.rs = (const float*)(ws + WS_SSQ);
      pg8::gemm_phase<pg8::Epi<pg8::EPI_P4>, pg8::StaticOrder, true, true>(ldsg, g, S, E); }
    }
    xcd_barrier(xbar);
    {   FRESH()
    { const int nA = (G >= 2) ? G / 2 : 1;
      if (bx < nA) { const int item0 = (nA % 8 == 0) ? (bx & 7) * (nA / 8) + (bx >> 3) : bx;
          fox::attn_phase((char*)lds, ws, item0, nA); }
      if (G < 2 || bx >= nA) { const int first = (G < 2) ? 0 : bx - nA, stride = (G < 2) ? 1 : G - nA;
          unsigned* ctr = (unsigned*)(ws + WS_BAR) + 4096;
          for (int u = first; u < 512; u += stride) gla_g1(ws, lds, u, tid);
          sub_barrier(ctr, (unsigned)stride);
          gla_g2(ws, first * 512 + tid, stride * 512);
          sub_barrier(ctr, 2u * (unsigned)stride);
          for (int u = first; u < 512; u += stride) gla_g3(a, lds, u, tid);
          convert_set<3>(a, lds, first * 8 + wave, stride * 8, wave, lane); } }
    }
    xcd_barrier(xbar);
    {   FRESH()
    { pg8::Gemm g{(const bf16*)(ws + WS_YF), (const bf16*)(ws + WS_WA), T, DM, 2048}; pg8::StaticOrder S; S.init(T, DM, G, bx);
      pg8::Epi<pg8::EPI_MERGE2> E{}; E.dstb = (bf16*)(ws + WS_XN); E.gates = (const bf16*)(ws + WS_GATES);
      pg8::gemm_phase<pg8::Epi<pg8::EPI_MERGE2>, pg8::StaticOrder, true, true>(ldsg, g, S, E); }
    }
    xcd_barrier(xbar);
    {   FRESH()
    { pg8::Gemm g{(const bf16*)(ws + WS_XN), (const bf16*)(ws + WS_WOUT), T, DM, DM}; pg8::StaticOrder S; S.init(T, DM, G, bx);
      pg8::Epi<pg8::EPI_RES> E{}; E.srcb = (const bf16*)H; E.dstf = nullptr; E.alpha = 1.0f; E.dstb = (bf16*)(ws + WS_XN2); E.ssq = (float*)(ws + WS_SSQ) + T;
      pg8::gemm_phase<pg8::Epi<pg8::EPI_RES>, pg8::StaticOrder, true, true>(ldsg, g, S, E); }
    }
    xcd_barrier(xbar);
    {   FRESH()
    { const int Gg = (G > 4 * NCONV) ? G - NCONV : G;
      if (bx < Gg) {
      pg8::Gemm g{(const bf16*)(ws + WS_XN2), (const bf16*)(ws + WS_WGU2), T, 2 * DFF, DM}; pg8::StaticOrder S; S.init(T, 2 * DFF, Gg, bx);
      pg8::Epi<pg8::EPI_SWIGLU> E{}; E.dstb = (bf16*)(ws + WS_ACT); E.rs = (const float*)(ws + WS_SSQ) + T;
      pg8::gemm_phase<pg8::Epi<pg8::EPI_SWIGLU>, pg8::StaticOrder, true, true>(ldsg, g, S, E); }
      if (Gg == G) convert_set<2>(a, lds, gw, NGW, wave, lane);
      else if (bx >= Gg) convert_set<2>(a, lds, (bx - Gg) * 8 + wave, (G - Gg) * 8, wave, lane);
      if (Gg == G || bx >= Gg) { const int Gc = (Gg == G) ? G : G - Gg, cx = (Gg == G) ? bx : bx - Gg;
          __syncthreads();
          pg8::Gemm g{(const bf16*)(ws + WS_PB), (const bf16*)(ws + WS_WPE), T, DM, PLE}; pg8::StaticOrder S; S.init(T, DM, Gc, cx);
          pg8::Epi<pg8::EPI_PE> E{}; E.dstb = (bf16*)(ws + WS_PE);
          pg8::gemm_phase<pg8::Epi<pg8::EPI_PE>, pg8::StaticOrder, true, true>(ldsg, g, S, E); } }
    }
    xcd_barrier(xbar);
    {   FRESH()
    { pg8::Gemm g{(const bf16*)(ws + WS_ACT), (const bf16*)(ws + WS_WD2), T, DM, DFF}; pg8::StaticOrder S; S.init(T, DM, G, bx);
      pg8::Epi<pg8::EPI_RES> E{}; E.srcb = (const bf16*)(ws + WS_XN2); E.dstf = nullptr; E.alpha = 0.5f; E.dstb = (bf16*)(ws + WS_XN); E.ssq = (float*)(ws + WS_SSQ) + 2 * T;
      pg8::gemm_phase<pg8::Epi<pg8::EPI_RES>, pg8::StaticOrder, true, true>(ldsg, g, S, E); }
    }
    xcd_barrier(xbar);
    {   FRESH()
    { pg8::Gemm g{(const bf16*)(ws + WS_XN), (const bf16*)(ws + WS_WPG), T, DM, DM}; pg8::StaticOrder S; S.init(T, DM, G, bx);
      if ((T / 256) * (DM / 256) <= G) {
      pg8::Epi<pg8::EPI_FINAL> E{}; E.pe = (const bf16*)(ws + WS_PE); E.srcb = (const bf16*)(ws + WS_XN); E.dstf = H; E.rs = (const float*)(ws + WS_SSQ) + 2 * T; E.ssq = (float*)(ws + WS_SSQ) + 3 * T;
      E.cnt = (unsigned*)(ws + WS_BAR) + 6144; E.gain = a.in[24];
      pg8::gemm_phase<pg8::Epi<pg8::EPI_FINAL>, pg8::StaticOrder, true, true>(ldsg, g, S, E);
      } else {
      pg8::Epi<pg8::EPI_PLE> E{}; E.pe = (const bf16*)(ws + WS_PE); E.srcb = (const bf16*)(ws + WS_XN); E.dstf = H; E.rs = (const float*)(ws + WS_SSQ) + 2 * T;
      pg8::gemm_phase<pg8::Epi<pg8::EPI_PLE>, pg8::StaticOrder, true, true>(ldsg, g, S, E);
      xcd_barrier(xbar);
      for (int m = gw; m < T; m += NGW) rms_row<true>(H + (size_t)m * DM, a.in[24], H + (size_t)m * DM, lane); } }

    }
}

extern "C" void kernel_launch(void* const* d_in, const int* in_sizes, int n_in, void* d_out, int out_size, void* d_ws, size_t ws_size, hipStream_t stream) {
    static int grid = 0;
    if (grid == 0) {
        if (n_in != 25 || out_size != T * DM || ws_size < WS_END) { fprintf(stderr, "kernel_launch: unexpected shapes (n_in %d out %d ws %zu need %zu)\n", n_in, out_size, ws_size, (size_t)WS_END); grid = -1; return; }
        int dev = 0, cus = 0, per_cu = 0;
        (void)hipGetDevice(&dev);
        (void)hipDeviceGetAttribute(&cus, hipDeviceAttributeMultiprocessorCount, dev);
        (void)hipFuncSetAttribute((const void*)fwd_kernel, hipFuncAttributeMaxDynamicSharedMemorySize, LDS_BYTES);
        (void)hipOccupancyMaxActiveBlocksPerMultiprocessor(&per_cu, (const void*)fwd_kernel, 512, LDS_BYTES);
        if (per_cu < 1) { fprintf(stderr, "kernel_launch: occupancy query says %d\n", per_cu); }
        (void)hipGetLastError();
        grid = cus > 0 ? cus : 256;
    }
    if (grid < 0) return;
    (void)hipMemsetAsync((unsigned char*)d_ws + WS_BAR, 0, 32768, stream);
    Args a{};
    for (int i = 0; i < 25; ++i) a.in[i] = (const float*)d_in[i];
    a.out = (float*)d_out; a.ws = (unsigned char*)d_ws;
    void* args[] = {&a};
    hipError_t e = hipLaunchCooperativeKernel((const void*)fwd_kernel, dim3(grid), dim3(512), args, LDS_BYTES, stream);
    if (e != hipSuccess) fprintf(stderr, "cooperative launch failed: %s (grid %d)\n", hipGetErrorString(e), grid);
}
```
